# Optimizing an MI355X kernel written in HIP

```python
import math
import jax, jax.numpy as jnp
from jax import lax
import numpy as np

D_MODEL = 1024
BATCH = 8
SEQ = 4096
DEPTH = 2

HEAD_DIM = 64
N_HEADS_DIFF = 4
N_HEADS_FOX = 4
N_HEADS_SB = 4
N_HEADS_DSA = 4
N_IDX_HEADS = 8
IDX_DIM = 64
TOPK_MAX = 256
ROPE_THETA = 500000.0
ROPE_DIM = HEAD_DIM // 4
Q_BLOCK = 128
D_FF = 2816
N_BRANCH = 4
NORM_EPS = 1e-6
SUBLN_EPS = 1e-5

W_DIFF = N_HEADS_DIFF * 2 * HEAD_DIM
W_FOX = N_HEADS_FOX * HEAD_DIM
W_SB = N_HEADS_SB * HEAD_DIM
W_DSA = N_HEADS_DSA * HEAD_DIM
IN_SPLITS = (
    W_DIFF, W_DIFF, W_DIFF,
    W_FOX, W_FOX, W_FOX, N_HEADS_FOX,
    W_SB, W_SB, W_SB,
    W_DSA, W_DSA, W_DSA, N_IDX_HEADS * IDX_DIM, IDX_DIM, N_IDX_HEADS,
)
IN_WIDTH = sum(IN_SPLITS)

kernel_name = "hybrid_gated_four_mixer_decoder"


def rms_norm(x, g, eps=NORM_EPS):
    xf = x.astype(jnp.float32)
    y = xf * lax.rsqrt(jnp.mean(xf * xf, axis=-1, keepdims=True) + eps)
    return (y * g.astype(jnp.float32)).astype(x.dtype)


def swiglu(x, w_gu, w_down):
    g, u = jnp.split(x @ w_gu, 2, axis=-1)
    return (jax.nn.silu(g) * u) @ w_down


def rope_tables(positions):
    freqs = ROPE_THETA ** (-jnp.arange(0, ROPE_DIM, 2, dtype=jnp.float32) / ROPE_DIM)
    ang = positions.astype(jnp.float32)[:, None] * freqs[None, :]
    return jnp.cos(ang), jnp.sin(ang)


def partial_rope(x, cos, sin):
    shape = (1, cos.shape[0]) + (1,) * (x.ndim - 3) + (cos.shape[1],)
    c = cos.reshape(shape).astype(x.dtype)
    s = sin.reshape(shape).astype(x.dtype)
    half = ROPE_DIM // 2
    x1, x2, xp = x[..., :half], x[..., half:ROPE_DIM], x[..., ROPE_DIM:]
    return jnp.concatenate([x1 * c - x2 * s, x2 * c + x1 * s, xp], axis=-1)


def sweep_query_blocks(block_fn, seq_len):
    n_blocks = seq_len // Q_BLOCK
    out = lax.map(block_fn, jnp.arange(n_blocks, dtype=jnp.int32) * Q_BLOCK)
    nb, b, blk, h, e = out.shape
    return jnp.moveaxis(out, 0, 1).reshape(b, nb * blk, h, e)


def diff_attention(q, k, v, lam):
    S = q.shape[1]
    scale = HEAD_DIM ** -0.5
    kpos = jnp.arange(S)

    def block(start):
        qb = lax.dynamic_slice_in_dim(q, start, Q_BLOCK, axis=1)
        qpos = start + jnp.arange(Q_BLOCK)
        causal = kpos[None, :] <= qpos[:, None]
        logits = jnp.einsum('bqhcd,bkhcd->bchqk', qb, k).astype(jnp.float32) * scale
        p = jax.nn.softmax(jnp.where(causal, logits, -jnp.inf), axis=-1)
        p = p[:, 0] - lam * p[:, 1]
        return jnp.einsum('bhqk,bkhe->bqhe', p.astype(v.dtype), v)

    return sweep_query_blocks(block, S)


def forgetting_attention(q, k, v, f_logits):
    S = q.shape[1]
    scale = HEAD_DIM ** -0.5
    kpos = jnp.arange(S)
    cum = jnp.transpose(jnp.cumsum(jax.nn.log_sigmoid(f_logits.astype(jnp.float32)), axis=1), (0, 2, 1))

    def block(start):
        qb = lax.dynamic_slice_in_dim(q, start, Q_BLOCK, axis=1)
        cq = lax.dynamic_slice_in_dim(cum, start, Q_BLOCK, axis=2)
        qpos = start + jnp.arange(Q_BLOCK)
        causal = kpos[None, :] <= qpos[:, None]
        logits = (jnp.einsum('bqhd,bkhd->bhqk', qb, k).astype(jnp.float32) * scale
                  + cq[..., :, None] - cum[:, :, None, :])
        p = jax.nn.softmax(jnp.where(causal, logits, -jnp.inf), axis=-1)
        return jnp.einsum('bhqk,bkhd->bqhd', p.astype(v.dtype), v)

    return sweep_query_blocks(block, S)


def stick_breaking_attention(q, k, v):
    S = q.shape[1]
    scale = HEAD_DIM ** -0.5
    kpos = jnp.arange(S)

    def block(start):
        qb = lax.dynamic_slice_in_dim(q, start, Q_BLOCK, axis=1)
        qpos = start + jnp.arange(Q_BLOCK)
        strict = kpos[None, :] < qpos[:, None]
        z = jnp.einsum('bqhd,bkhd->bhqk', qb, k).astype(jnp.float32) * scale
        log_1m = jnp.where(strict, jax.nn.log_sigmoid(-z), 0.0)
        after = lax.cumsum(log_1m, axis=3, reverse=True) - log_1m
        a = jnp.where(strict, jnp.exp(jax.nn.log_sigmoid(z) + after), 0.0)
        return jnp.einsum('bhqk,bkhd->bqhd', a.astype(v.dtype), v)

    return sweep_query_blocks(block, S)


def indexed_sparse_attention(q, k, v, iq, ik, iw, topk):
    B, S = q.shape[0], q.shape[1]
    scale = HEAD_DIM ** -0.5
    kpos = jnp.arange(S)
    bidx = jnp.arange(B)[:, None, None]

    def block(start):
        qb = lax.dynamic_slice_in_dim(q, start, Q_BLOCK, axis=1)
        iqb = lax.dynamic_slice_in_dim(iq, start, Q_BLOCK, axis=1)
        iwb = lax.dynamic_slice_in_dim(iw, start, Q_BLOCK, axis=1)
        qpos = start + jnp.arange(Q_BLOCK)
        causal = kpos[None, :] <= qpos[:, None]
        rel = jax.nn.relu(jnp.einsum('bqhd,bkd->bqhk', iqb, ik).astype(jnp.float32))
        score = jnp.einsum('bqhk,bqh->bqk', rel, iwb.astype(jnp.float32))
        score = jnp.where(causal[None], score, -jnp.inf)
        _, idx = lax.top_k(score, topk)
        valid = idx <= qpos[None, :, None]
        k_sel = k[bidx, idx]
        v_sel = v[bidx, idx]
        logits = jnp.einsum('bqhd,bqjhd->bhqj', qb, k_sel).astype(jnp.float32) * scale
        p = jax.nn.softmax(jnp.where(valid[:, None], logits, -jnp.inf), axis=-1)
        return jnp.einsum('bhqj,bqjhd->bqhd', p.astype(v.dtype), v_sel)

    return sweep_query_blocks(block, S)


def hybrid_mixer(h, cos, sin, layer_idx, w_in, b_fgt, lam_q1, lam_k1, lam_q2, lam_k2, diff_gain,
                 w_gate, b_gate, w_br_a, w_br_b, w_br_c, w_br_d, w_out):
    B, S, D = h.shape
    points = np.cumsum(IN_SPLITS)[:-1].tolist()
    (aq, ak, av, bq, bk, bv, bf, cq, ck, cv,
     dq, dk, dv, diq, dik, diw) = jnp.split(h @ w_in, points, axis=-1)

    lam_init = 0.8 - 0.6 * math.exp(-0.3 * layer_idx)
    lam = (jnp.exp(jnp.sum(lam_q1.astype(jnp.float32) * lam_k1.astype(jnp.float32)))
           - jnp.exp(jnp.sum(lam_q2.astype(jnp.float32) * lam_k2.astype(jnp.float32))) + lam_init)
    qa = partial_rope(aq.reshape(B, S, N_HEADS_DIFF, 2, HEAD_DIM), cos, sin)
    ka = partial_rope(ak.reshape(B, S, N_HEADS_DIFF, 2, HEAD_DIM), cos, sin)
    ya = diff_attention(qa, ka, av.reshape(B, S, N_HEADS_DIFF, 2 * HEAD_DIM), lam)
    ya = (rms_norm(ya, diff_gain, SUBLN_EPS) * (1.0 - lam_init)).reshape(B, S, W_DIFF)

    yb = forgetting_attention(bq.reshape(B, S, N_HEADS_FOX, HEAD_DIM),
                              bk.reshape(B, S, N_HEADS_FOX, HEAD_DIM),
                              bv.reshape(B, S, N_HEADS_FOX, HEAD_DIM),
                              bf + b_fgt).reshape(B, S, W_FOX)

    yc = stick_breaking_attention(cq.reshape(B, S, N_HEADS_SB, HEAD_DIM),
                                  ck.reshape(B, S, N_HEADS_SB, HEAD_DIM),
                                  cv.reshape(B, S, N_HEADS_SB, HEAD_DIM)).reshape(B, S, W_SB)

    topk = min(TOPK_MAX, S // 4)
    qd = partial_rope(dq.reshape(B, S, N_HEADS_DSA, HEAD_DIM), cos, sin)
    kd = partial_rope(dk.reshape(B, S, N_HEADS_DSA, HEAD_DIM), cos, sin)
    iq = partial_rope(diq.reshape(B, S, N_IDX_HEADS, IDX_DIM), cos, sin)
    ik = partial_rope(dik, cos, sin)
    yd = indexed_sparse_attention(qd, kd, dv.reshape(B, S, N_HEADS_DSA, HEAD_DIM),
                                  iq, ik, diw, topk).reshape(B, S, W_DSA)

    g = jax.nn.sigmoid(h @ w_gate + b_gate).reshape(B, S, N_BRANCH, D)
    merged = (g[:, :, 0] * (ya @ w_br_a) + g[:, :, 1] * (yb @ w_br_b)
              + g[:, :, 2] * (yc @ w_br_c) + g[:, :, 3] * (yd @ w_br_d))
    return merged @ w_out


def setup_inputs(seed: int = 0) -> dict:
    key = jax.random.key(seed)
    ks = iter(jax.random.split(key, 32))
    f32 = jnp.float32

    def nrm(shape, scale):
        return jax.random.normal(next(ks), shape, f32) * scale

    def gain(shape):
        return 1.0 + 0.02 * jax.random.normal(next(ks), shape, f32)

    L, D, F = DEPTH, D_MODEL, D_FF
    return {
        "x": jax.random.normal(next(ks), (BATCH, SEQ, D), f32),
        "positions": jnp.arange(SEQ, dtype=jnp.int32),
        "ffn1_norm": gain((L, D)),
        "ffn1_w_gu": nrm((L, D, 2 * F), D ** -0.5),
        "ffn1_w_down": nrm((L, F, D), F ** -0.5),
        "mix_norm": gain((L, D)),
        "w_in": nrm((L, D, IN_WIDTH), D ** -0.5),
        "b_fgt": 2.0 + 0.5 * jax.random.normal(next(ks), (L, N_HEADS_FOX), f32),
        "lam_q1": nrm((L, HEAD_DIM), 0.1),
        "lam_k1": nrm((L, HEAD_DIM), 0.1),
        "lam_q2": nrm((L, HEAD_DIM), 0.1),
        "lam_k2": nrm((L, HEAD_DIM), 0.1),
        "diff_gain": gain((L, 2 * HEAD_DIM)),
        "w_gate": nrm((L, D, N_BRANCH * D), D ** -0.5),
        "b_gate": nrm((L, N_BRANCH * D), 0.01),
        "w_br_a": nrm((L, W_DIFF, D), W_DIFF ** -0.5),
        "w_br_b": nrm((L, W_FOX, D), W_FOX ** -0.5),
        "w_br_c": nrm((L, W_SB, D), W_SB ** -0.5),
        "w_br_d": nrm((L, W_DSA, D), W_DSA ** -0.5),
        "w_out": nrm((L, D, D), 0.5 * D ** -0.5),
        "ffn2_norm": gain((L, D)),
        "ffn2_w_gu": nrm((L, D, 2 * F), D ** -0.5),
        "ffn2_w_down": nrm((L, F, D), F ** -0.5),
        "final_norm": gain((D,)),
    }


def reference(x, positions, ffn1_norm, ffn1_w_gu, ffn1_w_down, mix_norm, w_in, b_fgt,
              lam_q1, lam_k1, lam_q2, lam_k2, diff_gain, w_gate, b_gate,
              w_br_a, w_br_b, w_br_c, w_br_d, w_out, ffn2_norm, ffn2_w_gu, ffn2_w_down,
              final_norm):
    cos, sin = rope_tables(positions)
    for l in range(DEPTH):
        x = x + 0.5 * swiglu(rms_norm(x, ffn1_norm[l]), ffn1_w_gu[l], ffn1_w_down[l])
        x = x + hybrid_mixer(rms_norm(x, mix_norm[l]), cos, sin, l, w_in[l], b_fgt[l],
                             lam_q1[l], lam_k1[l], lam_q2[l], lam_k2[l], diff_gain[l],
                             w_gate[l], b_gate[l], w_br_a[l], w_br_b[l], w_br_c[l], w_br_d[l],
                             w_out[l])
        x = x + 0.5 * swiglu(rms_norm(x, ffn2_norm[l]), ffn2_w_gu[l], ffn2_w_down[l])
    return rms_norm(x, final_norm)
```

```cpp
#include <hip/hip_runtime.h>
#include <hip/hip_cooperative_groups.h>
#include <cstdio>
namespace cg = cooperative_groups;

#define DI __device__ __forceinline__
typedef unsigned short u16;
typedef unsigned long long u64;
typedef __attribute__((ext_vector_type(8))) short bf16x8;
typedef __attribute__((ext_vector_type(16))) float f32x16;
typedef __attribute__((ext_vector_type(4))) float f32x4;
typedef __attribute__((ext_vector_type(2))) float f32x2;
typedef __attribute__((ext_vector_type(2))) __bf16 bf2;
typedef __attribute__((ext_vector_type(4))) unsigned u32x4;
typedef __attribute__((ext_vector_type(2))) unsigned u32x2;

constexpr int D = 1024, NB = 8, S = 4096, M = NB * S, DFF = 2816;
constexpr int NPR = 3200, NV = 1280, NY = 1280;
constexpr int AQ = 0, AK = 512, BQ = 1024, BKo = 1280, CQ = 1536, CK = 1792, DQ = 2048, DK = 2304, IQ = 2560, IK = 3072, SMALL = 3136;
constexpr size_t OFF_GU1 = 0;
constexpr size_t OFF_DN1 = OFF_GU1 + (size_t)5632 * 1024;
constexpr size_t OFF_IN = OFF_DN1 + (size_t)1024 * 2816;
constexpr size_t OFF_GATE = OFF_IN + (size_t)4608 * 1024;
constexpr size_t OFF_BRA = OFF_GATE + (size_t)4096 * 1024;
constexpr size_t OFF_BRB = OFF_BRA + (size_t)1024 * 512;
constexpr size_t OFF_BRC = OFF_BRB + (size_t)1024 * 256;
constexpr size_t OFF_BRD = OFF_BRC + (size_t)1024 * 256;
constexpr size_t OFF_OUT = OFF_BRD + (size_t)1024 * 256;
constexpr size_t OFF_GU2 = OFF_OUT + (size_t)1024 * 1024;
constexpr size_t OFF_DN2 = OFF_GU2 + (size_t)5632 * 1024;
constexpr size_t WT_ELEMS = OFF_DN2 + (size_t)1024 * 2816;

constexpr float LOG2E = 1.4426950408889634f;
constexpr int LDS_BYTES = 131072;
constexpr int ROWB = 144;

struct P {
  const float* in[24];
  const int* pos;
  float* xres;
  u16* Wt; u16* hb; u16* PR; u16* VT; u16* Y;
  unsigned* MASK; float* FL; float* IW; float* CUM; float* COS; float* SIN;
};

DI int TID() { int t = (int)__builtin_amdgcn_workitem_id_x(); asm volatile("" : "+v"(t)); return t; }
DI unsigned pk2(float a, float b) { f32x2 v = {a, b}; bf2 r = __builtin_convertvector(v, bf2); return __builtin_bit_cast(unsigned, r); }
DI u16 f2bf(float a) { __bf16 h = (__bf16)a; return __builtin_bit_cast(u16, h); }
DI float wsum(float v) {
#pragma unroll
  for (int o = 32; o > 0; o >>= 1) v += __shfl_xor(v, o);
  return v;
}
DI float xmax32(float x) { auto r2 = __builtin_amdgcn_permlane32_swap(__float_as_uint(x), __float_as_uint(x), false, false); return fmaxf(__uint_as_float(r2[0]), __uint_as_float(r2[1])); }
DI float xsum32(float x) { auto r2 = __builtin_amdgcn_permlane32_swap(__float_as_uint(x), __float_as_uint(x), false, false); return __uint_as_float(r2[0]) + __uint_as_float(r2[1]); }
DI float xoth32(float x, int hh) { auto r2 = __builtin_amdgcn_permlane32_swap(__float_as_uint(x), __float_as_uint(x), false, false); return __uint_as_float(hh ? r2[0] : r2[1]); }
DI constexpr int crow(int i, int hh) { return (i & 3) + 8 * (i >> 2) + 4 * hh; }
DI f32x16 mfma(bf16x8 a, bf16x8 b, f32x16 c) { return __builtin_amdgcn_mfma_f32_32x32x16_bf16(a, b, c, 0, 0, 0); }
DI f32x16 zero16() { f32x16 z;
#pragma unroll
  for (int i = 0; i < 16; ++i) z[i] = 0.f; return z; }

DI void phase_norm(const float* __restrict__ src, const float* __restrict__ g, u16* __restrict__ dst) {
  const int lane = TID() & 63;
  const int wave = (blockIdx.x * 512 + TID()) >> 6, nw = gridDim.x * 8;
  for (int row = wave; row < M; row += nw) {
    const f32x4* p = (const f32x4*)(src + (size_t)row * D);
    f32x4 v[4]; float ss = 0.f;
#pragma unroll
    for (int j = 0; j < 4; ++j) { v[j] = p[lane + 64 * j]; ss += v[j][0] * v[j][0] + v[j][1] * v[j][1] + v[j][2] * v[j][2] + v[j][3] * v[j][3]; }
    ss = wsum(ss);
    const float rs = rsqrtf(ss * (1.f / D) + 1e-6f);
#pragma unroll
    for (int j = 0; j < 4; ++j) {
      f32x4 gg = ((const f32x4*)g)[lane + 64 * j];
      u32x2 o; o[0] = pk2(v[j][0] * rs * gg[0], v[j][1] * rs * gg[1]); o[1] = pk2(v[j][2] * rs * gg[2], v[j][3] * rs * gg[3]);
      *(u32x2*)(dst + (size_t)row * D + (lane + 64 * j) * 4) = o;
    }
  }
}
DI void phase_final_norm(float* __restrict__ x, const float* __restrict__ g) {
  const int lane = TID() & 63;
  const int wave = (blockIdx.x * 512 + TID()) >> 6, nw = gridDim.x * 8;
  for (int row = wave; row < M; row += nw) {
    f32x4* p = (f32x4*)(x + (size_t)row * D);
    f32x4 v[4]; float ss = 0.f;
#pragma unroll
    for (int j = 0; j < 4; ++j) { v[j] = p[lane + 64 * j]; ss += v[j][0] * v[j][0] + v[j][1] * v[j][1] + v[j][2] * v[j][2] + v[j][3] * v[j][3]; }
    ss = wsum(ss);
    const float rs = rsqrtf(ss * (1.f / D) + 1e-6f);
#pragma unroll
    for (int j = 0; j < 4; ++j) {
      f32x4 gg = ((const f32x4*)g)[lane + 64 * j];
      f32x4 o; o[0] = v[j][0] * rs * gg[0]; o[1] = v[j][1] * rs * gg[1]; o[2] = v[j][2] * rs * gg[2]; o[3] = v[j][3] * rs * gg[3];
      p[lane + 64 * j] = o;
    }
  }
}

DI int map_gu(int n) { int c = (n < DFF) ? n : n - DFF; return (c >> 5) * 64 + (c & 31) + ((n < DFF) ? 0 : 32); }
DI int map_in(int n) {
  if (n < 512) return n;
  if (n < 1024) return n;
  if (n < 1536) return n - 1024 + 3200;
  if (n < 1792) return n - 1536 + BQ;
  if (n < 2048) return n - 1792 + BKo;
  if (n < 2304) return n - 2048 + 3200 + 512;
  if (n < 2308) return n - 2304 + SMALL;
  if (n < 2564) return n - 2308 + CQ;
  if (n < 2820) return n - 2564 + CK;
  if (n < 3076) return n - 2820 + 3200 + 768;
  if (n < 3332) return n - 3076 + DQ;
  if (n < 3588) return n - 3332 + DK;
  if (n < 3844) return n - 3588 + 3200 + 1024;
  if (n < 4356) return n - 3844 + IQ;
  if (n < 4420) return n - 4356 + IK;
  return n - 4420 + SMALL + 4;
}
DI void conv_w(const float* __restrict__ W, int K, int N, u16* __restrict__ Wt, int mp, char* lds) {
  const int tid = TID(), half = tid >> 8, t8 = tid & 255, tn = t8 & 15, tk = t8 >> 4;
  char* my = lds + half * (64 * ROWB);
  const int ntn = (N + 63) >> 6, ntk = K >> 6, ntile = ntn * ntk;
  for (int base = 2 * blockIdx.x; base < ntile; base += 2 * gridDim.x) {
    const int tile = base + half;
    const bool on = tile < ntile;
    const int n0 = (tile % ntn) * 64, k0 = (tile / ntn) * 64;
    f32x4 v[4];
    const int n = n0 + 4 * tn;
#pragma unroll
    for (int i = 0; i < 4; ++i) {
      if (on && n < N) v[i] = *(const f32x4*)(W + (size_t)(k0 + 4 * tk + i) * N + n);
      else { v[i][0] = 0.f; v[i][1] = 0.f; v[i][2] = 0.f; v[i][3] = 0.f; }
    }
    __syncthreads();
#pragma unroll
    for (int j = 0; j < 4; ++j) {
      u32x2 w; w[0] = pk2(v[0][j], v[1][j]); w[1] = pk2(v[2][j], v[3][j]);
      *(u32x2*)(my + (4 * tn + j) * ROWB + tk * 8) = w;
    }
    __syncthreads();
#pragma unroll
    for (int ps = 0; ps < 2; ++ps) {
      const int nn = (t8 >> 3) + 32 * ps, c = t8 & 7, ng = n0 + nn;
      if (on && ng < N) {
        const int np = (mp == 0) ? ng : (mp == 1 ? map_gu(ng) : map_in(ng));
        *(u32x4*)(Wt + (size_t)np * K + k0 + 8 * c) = *(const u32x4*)(my + nn * ROWB + c * 16);
      }
    }
  }
}
DI void phase_conv(const P& p, int l, char* lds) {
  conv_w(p.in[3] + (size_t)l * 1024 * 5632, 1024, 5632, p.Wt + OFF_GU1, 1, lds);
  conv_w(p.in[4] + (size_t)l * 2816 * 1024, 2816, 1024, p.Wt + OFF_DN1, 0, lds);
  conv_w(p.in[6] + (size_t)l * 1024 * 4428, 1024, 4428, p.Wt + OFF_IN, 2, lds);
  conv_w(p.in[13] + (size_t)l * 1024 * 4096, 1024, 4096, p.Wt + OFF_GATE, 0, lds);
  conv_w(p.in[15] + (size_t)l * 512 * 1024, 512, 1024, p.Wt + OFF_BRA, 0, lds);
  conv_w(p.in[16] + (size_t)l * 256 * 1024, 256, 1024, p.Wt + OFF_BRB, 0, lds);
  conv_w(p.in[17] + (size_t)l * 256 * 1024, 256, 1024, p.Wt + OFF_BRC, 0, lds);
  conv_w(p.in[18] + (size_t)l * 256 * 1024, 256, 1024, p.Wt + OFF_BRD, 0, lds);
  conv_w(p.in[19] + (size_t)l * 1024 * 1024, 1024, 1024, p.Wt + OFF_OUT, 0, lds);
  conv_w(p.in[21] + (size_t)l * 1024 * 5632, 1024, 5632, p.Wt + OFF_GU2, 1, lds);
  conv_w(p.in[22] + (size_t)l * 2816 * 1024, 2816, 1024, p.Wt + OFF_DN2, 0, lds);
  const int gt = blockIdx.x * 512 + TID(), nt = gridDim.x * 512;
  for (int i = gt; i < 52 * 1024; i += nt) p.Wt[OFF_IN + (size_t)3148 * 1024 + i] = 0;
  for (int i = gt; i < 128 * 1024; i += nt) p.Wt[OFF_IN + (size_t)4480 * 1024 + i] = 0;
  if (l == 0) {
    for (int i = gt; i < S * 8; i += nt) {
      const int s = i >> 3, c = i & 7;
      const float freq = powf(500000.0f, -(float)(2 * c) / 16.0f);
      const float ang = (float)p.pos[s] * freq;
      p.COS[i] = cosf(ang); p.SIN[i] = sinf(ang);
    }
  }
}

#define LAS __attribute__((address_space(3)))
template <int WF, int WT, int WGT, int PF = 1>
DI void gemm_loop(const u16* __restrict__ A, size_t lda, const u16* __restrict__ B, size_t ldb, int K, f32x16 (&acc)[WF][WT], char* lds) {
  constexpr int WGF = 8 / WGT;
  constexpr int BF = 32 * WF * WGF, BT = 32 * WT * WGT;
  constexpr int ABYTES = BF * 128, BBYTES = BT * 128, STAGE = ABYTES + BBYTES;
  constexpr int IA = BF / 64, IB = BT / 64;
  static_assert(2 * STAGE <= LDS_BYTES, "lds");
  const int tid = TID(), lane = tid & 63, wave = tid >> 6;
  const int wf = wave / WGT, wt = wave % WGT, r = lane & 31, hh = lane >> 5;
  const int kcs = (tid & 7) ^ ((tid >> 4) & 7);
  const u16* ga = A + (size_t)(tid >> 3) * lda + kcs * 8;
  const u16* gb = B + (size_t)(tid >> 3) * ldb + kcs * 8;
  LAS char* l3 = (LAS char*)lds;
  const int sw = (r >> 1) & 7;
  __syncthreads();
#pragma unroll
  for (int i = 0; i < IA; ++i) __builtin_amdgcn_global_load_lds((const unsigned*)(ga + (size_t)i * 64 * lda), (LAS unsigned*)(l3 + i * 8192 + wave * 1024), 16, 0, 0);
#pragma unroll
  for (int i = 0; i < IB; ++i) __builtin_amdgcn_global_load_lds((const unsigned*)(gb + (size_t)i * 64 * ldb), (LAS unsigned*)(l3 + ABYTES + i * 8192 + wave * 1024), 16, 0, 0);
  const int nk = K >> 6;
  for (int kt = 0; kt < nk; ++kt) {
    __syncthreads();
    if (kt + 1 < nk) {
      const int nb = ((kt + 1) & 1) * STAGE, k0 = (kt + 1) * 64;
#pragma unroll
      for (int i = 0; i < IA; ++i) __builtin_amdgcn_global_load_lds((const unsigned*)(ga + (size_t)i * 64 * lda + k0), (LAS unsigned*)(l3 + nb + i * 8192 + wave * 1024), 16, 0, 0);
#pragma unroll
      for (int i = 0; i < IB; ++i) __builtin_amdgcn_global_load_lds((const unsigned*)(gb + (size_t)i * 64 * ldb + k0), (LAS unsigned*)(l3 + nb + ABYTES + i * 8192 + wave * 1024), 16, 0, 0);
    }
    const char* sa = lds + (kt & 1) * STAGE;
    const char* sb = sa + ABYTES;
    bf16x8 af[PF + 1][WF], bfr[PF + 1][WT];
    if (PF) {
      const int co = ((0 * 2 + hh) ^ sw) << 4;
#pragma unroll
      for (int f = 0; f < WF; ++f) af[0][f] = *(const bf16x8*)(sa + ((wf * WF + f) * 32 + r) * 128 + co);
#pragma unroll
      for (int t = 0; t < WT; ++t) bfr[0][t] = *(const bf16x8*)(sb + ((wt * WT + t) * 32 + r) * 128 + co);
    }
#pragma unroll
    for (int ks = 0; ks < 4; ++ks) {
      const int ld = PF ? ks + 1 : ks, li = PF ? ((ks + 1) & 1) : 0, ci = PF ? (ks & 1) : 0;
      if (ld < 4) {
        const int co = ((ld * 2 + hh) ^ sw) << 4;
#pragma unroll
        for (int f = 0; f < WF; ++f) af[li][f] = *(const bf16x8*)(sa + ((wf * WF + f) * 32 + r) * 128 + co);
#pragma unroll
        for (int t = 0; t < WT; ++t) bfr[li][t] = *(const bf16x8*)(sb + ((wt * WT + t) * 32 + r) * 128 + co);
      }
#pragma unroll
      for (int f = 0; f < WF; ++f)
#pragma unroll
        for (int t = 0; t < WT; ++t) acc[f][t] = mfma(af[ci][f], bfr[ci][t], acc[f][t]);
    }
    __syncthreads();
  }
}
DI bool tile_at(int round, int NF, int ntiles, int& ft, int& tt) {
  const int G8 = gridDim.x >> 3;
  const int L = (round * 8 + (int)(blockIdx.x & 7)) * G8 + (int)(blockIdx.x >> 3);
  if (L >= ntiles) return false;
  const int tg = L / (NF * 8), rem = L - tg * NF * 8;
  ft = rem >> 3; tt = tg * 8 + (rem & 7);
  return true;
}

DI void phase_gu(const P& p, const u16* __restrict__ Wt, u16* __restrict__ act, char* lds) {
  const int lane = TID() & 63, wave = TID() >> 6, wf = wave >> 2, wt = wave & 3, r = lane & 31, hh = lane >> 5;
  for (int rnd = 0; rnd * (int)gridDim.x < 22 * 128; ++rnd) {
    int ft, tt; if (!tile_at(rnd, 22, 22 * 128, ft, tt)) continue;
    f32x16 acc[4][2];
#pragma unroll
    for (int f = 0; f < 4; ++f)
#pragma unroll
      for (int t = 0; t < 2; ++t) acc[f][t] = zero16();
    gemm_loop<4, 2, 4>(Wt + (size_t)ft * 256 * 1024, 1024, p.hb + (size_t)tt * 256 * 1024, 1024, 1024, acc, lds);
#pragma unroll
    for (int t = 0; t < 2; ++t) {
      const int token = tt * 256 + (wt * 2 + t) * 32 + r;
#pragma unroll
      for (int pr = 0; pr < 2; ++pr) {
        const int c0 = ft * 128 + wf * 64 + pr * 32;
#pragma unroll
        for (int g4 = 0; g4 < 4; ++g4) {
          float o[4];
#pragma unroll
          for (int j = 0; j < 4; ++j) { const float g = acc[2 * pr][t][4 * g4 + j], u = acc[2 * pr + 1][t][4 * g4 + j]; o[j] = g * __builtin_amdgcn_rcpf(1.f + __builtin_amdgcn_exp2f(-LOG2E * g)) * u; }
          u32x2 w; w[0] = pk2(o[0], o[1]); w[1] = pk2(o[2], o[3]);
          *(u32x2*)(act + (size_t)token * DFF + c0 + 8 * g4 + 4 * hh) = w;
        }
      }
    }
  }
}
DI void phase_resid(const u16* __restrict__ Wt, const u16* __restrict__ B, int K, const float* __restrict__ xsrc, float* __restrict__ xout, float alpha, char* lds) {
  const int lane = TID() & 63, wave = TID() >> 6, wf = wave >> 2, wt = wave & 3, r = lane & 31, hh = lane >> 5;
  for (int rnd = 0; rnd * (int)gridDim.x < 4 * 128; ++rnd) {
    int ft, tt; if (!tile_at(rnd, 4, 4 * 128, ft, tt)) continue;
    f32x16 acc[4][2];
#pragma unroll
    for (int f = 0; f < 4; ++f)
#pragma unroll
      for (int t = 0; t < 2; ++t) acc[f][t] = zero16();
    gemm_loop<4, 2, 4>(Wt + (size_t)ft * 256 * K, K, B + (size_t)tt * 256 * K, K, K, acc, lds);
#pragma unroll
    for (int f = 0; f < 4; ++f)
#pragma unroll
      for (int t = 0; t < 2; ++t) {
        const int token = tt * 256 + (wt * 2 + t) * 32 + r;
        const int fb = ft * 256 + (wf * 4 + f) * 32;
#pragma unroll
        for (int g4 = 0; g4 < 4; ++g4) {
          const size_t off = (size_t)token * D + fb + 8 * g4 + 4 * hh;
          f32x4 xv = *(const f32x4*)(xsrc + off);
#pragma unroll
          for (int j = 0; j < 4; ++j) xv[j] += alpha * acc[f][t][4 * g4 + j];
          *(f32x4*)(xout + off) = xv;
        }
      }
  }
}
DI void phase_proj(const P& p, int l, char* lds) {
  const int lane = TID() & 63, wave = TID() >> 6, wf = wave >> 2, wt = wave & 3, r = lane & 31, hh = lane >> 5;
  const float* bf = p.in[7] + l * 4;
  for (int rnd = 0; rnd * (int)gridDim.x < 18 * 128; ++rnd) {
    int ft, tt; if (!tile_at(rnd, 18, 18 * 128, ft, tt)) continue;
    f32x16 acc[4][2];
#pragma unroll
    for (int f = 0; f < 4; ++f)
#pragma unroll
      for (int t = 0; t < 2; ++t) acc[f][t] = zero16();
    gemm_loop<4, 2, 4>(p.Wt + OFF_IN + (size_t)ft * 256 * 1024, 1024, p.hb + (size_t)tt * 256 * 1024, 1024, 1024, acc, lds);
#pragma unroll
    for (int f = 0; f < 4; ++f)
#pragma unroll
      for (int t = 0; t < 2; ++t) {
        const int token = tt * 256 + (wt * 2 + t) * 32 + r;
        const int fb = ft * 256 + (wf * 4 + f) * 32;
        const int sidx = token & (S - 1), b = token >> 12;
        if (fb < 3200) {
          const bool rope = ((fb & 63) == 0) && (fb < 1024 || (fb >= 2048 && fb < SMALL));
          if (rope) {
            const f32x4 cs = *(const f32x4*)(p.COS + sidx * 8 + 4 * hh);
            const f32x4 sn = *(const f32x4*)(p.SIN + sidx * 8 + 4 * hh);
#pragma unroll
            for (int j = 0; j < 4; ++j) {
              const float x1 = acc[f][t][j], x2 = acc[f][t][4 + j];
              acc[f][t][j] = x1 * cs[j] - x2 * sn[j];
              acc[f][t][4 + j] = x2 * cs[j] + x1 * sn[j];
            }
          }
          const bool isq = (fb < 512) || (fb >= BQ && fb < BKo) || (fb >= CQ && fb < CK) || (fb >= DQ && fb < DK);
          if (isq) acc[f][t] = acc[f][t] * (0.125f * LOG2E);
          if (fb == SMALL) {
            if (hh == 0) {
#pragma unroll
              for (int j = 0; j < 4; ++j) {
                const float z = acc[f][t][j] + bf[j];
                p.FL[(size_t)token * 4 + j] = fminf(z, 0.f) - __logf(1.f + __expf(-fabsf(z)));
                p.IW[(size_t)token * 8 + 4 + j] = acc[f][t][4 + j];
              }
            } else {
#pragma unroll
              for (int j = 0; j < 4; ++j) p.IW[(size_t)token * 8 + j] = acc[f][t][j];
            }
          }
#pragma unroll
          for (int g4 = 0; g4 < 4; ++g4) {
            u32x2 w; w[0] = pk2(acc[f][t][4 * g4], acc[f][t][4 * g4 + 1]); w[1] = pk2(acc[f][t][4 * g4 + 2], acc[f][t][4 * g4 + 3]);
            *(u32x2*)(p.PR + (size_t)token * NPR + fb + 8 * g4 + 4 * hh) = w;
          }
        } else if (fb < 4480) {
          const int vf0 = fb - 3200;
#pragma unroll
          for (int i = 0; i < 16; ++i) p.VT[((size_t)(b * NV + vf0 + crow(i, hh))) * S + sidx] = f2bf(acc[f][t][i]);
        }
      }
  }
}
DI void phase_merge(const P& p, int l, u16* __restrict__ merged, char* lds) {
  const int lane = TID() & 63, wave = TID() >> 6, wf = wave >> 2, wt = wave & 3, r = lane & 31, hh = lane >> 5;
  const float* bg = p.in[14] + (size_t)l * 4096;
  for (int rnd = 0; rnd * (int)gridDim.x < 8 * 128; ++rnd) {
    int ft, tt; if (!tile_at(rnd, 8, 8 * 128, ft, tt)) continue;
    const int f0 = ft * 128;
    f32x16 accM[2][2];
#pragma unroll
    for (int f = 0; f < 2; ++f)
#pragma unroll
      for (int t = 0; t < 2; ++t) accM[f][t] = zero16();
    for (int br = 0; br < 4; ++br) {
      f32x16 acc[2][2];
#pragma unroll
      for (int f = 0; f < 2; ++f)
#pragma unroll
        for (int t = 0; t < 2; ++t) acc[f][t] = zero16();
      gemm_loop<2, 2, 4, 0>(p.Wt + OFF_GATE + (size_t)(br * 1024 + f0) * 1024, 1024, p.hb + (size_t)tt * 256 * 1024, 1024, 1024, acc, lds);
      unsigned gp[2][2][8];
      const int tq = TID(), wfq = tq >> 8, hq = (tq >> 5) & 1;
      const float* bq = bg + br * 1024 + f0 + wfq * 64 + 4 * hq;
#pragma unroll
      for (int f = 0; f < 2; ++f)
#pragma unroll
        for (int j = 0; j < 8; ++j) {
          const float b0 = bq[f * 32 + crow(2 * j, 0)];
          const float b1 = bq[f * 32 + crow(2 * j + 1, 0)];
#pragma unroll
          for (int t = 0; t < 2; ++t) {
            const float g0 = __builtin_amdgcn_rcpf(1.f + __builtin_amdgcn_exp2f(-LOG2E * (acc[f][t][2 * j] + b0)));
            const float g1 = __builtin_amdgcn_rcpf(1.f + __builtin_amdgcn_exp2f(-LOG2E * (acc[f][t][2 * j + 1] + b1)));
            gp[f][t][j] = pk2(g0, g1);
          }
        }
#pragma unroll
      for (int f = 0; f < 2; ++f)
#pragma unroll
        for (int t = 0; t < 2; ++t) acc[f][t] = zero16();
      const int Kb = (br == 0) ? 512 : 256;
      const size_t woff = (br == 0) ? OFF_BRA : OFF_BRB + (size_t)(br - 1) * 1024 * 256;
      const int yoff = (br == 0) ? 0 : 512 + 256 * (br - 1);
      gemm_loop<2, 2, 4, 0>(p.Wt + woff + (size_t)f0 * Kb, Kb, p.Y + (size_t)tt * 256 * NY + yoff, NY, Kb, acc, lds);
#pragma unroll
      for (int f = 0; f < 2; ++f)
#pragma unroll
        for (int t = 0; t < 2; ++t)
#pragma unroll
          for (int j = 0; j < 8; ++j) {
            const unsigned u = gp[f][t][j];
            accM[f][t][2 * j] += __uint_as_float(u << 16) * acc[f][t][2 * j];
            accM[f][t][2 * j + 1] += __uint_as_float(u & 0xffff0000u) * acc[f][t][2 * j + 1];
          }
    }
#pragma unroll
    for (int f = 0; f < 2; ++f)
#pragma unroll
      for (int t = 0; t < 2; ++t) {
        const int token = tt * 256 + (wt * 2 + t) * 32 + r;
#pragma unroll
        for (int g4 = 0; g4 < 4; ++g4) {
          u32x2 w; w[0] = pk2(accM[f][t][4 * g4], accM[f][t][4 * g4 + 1]); w[1] = pk2(accM[f][t][4 * g4 + 2], accM[f][t][4 * g4 + 3]);
          *(u32x2*)(merged + (size_t)token * D + f0 + (wf * 2 + f) * 32 + 8 * g4 + 4 * hh) = w;
        }
      }
  }
}

template <int VAR, int DV>
DI void attn_core(const P& p, int b, int q0, int qoff, int koff, int vf0, int hfox, char* lds, f32x16 (&O)[DV / 32], float& lsum) {
  const int tid = TID(), lane = tid & 63, wave = tid >> 6, r = lane & 31, hh = lane >> 5;
  char* Kt = lds; char* Vt = lds + 64 * ROWB; float* cumt = (float*)(lds + 64 * ROWB + DV * ROWB);
  const int qw = q0 + wave * 32, query = qw + r;
  constexpr float SC2 = 0.125f * LOG2E;
  bf16x8 qf[4];
  {
    const u16* qp = p.PR + (size_t)(b * S + query) * NPR + qoff;
#pragma unroll
    for (int ks = 0; ks < 4; ++ks) qf[ks] = *(const bf16x8*)(qp + ks * 16 + hh * 8);
  }
#pragma unroll
  for (int db = 0; db < DV / 32; ++db) O[db] = zero16();
  float m = -INFINITY, l = 0.f, R = (VAR == 2) ? 1.f : 0.f, cq = 0.f;
  if (VAR == 1) cq = p.CUM[(size_t)(b * 4 + hfox) * S + query];
  const float cq2 = cq * LOG2E;
  const int nkt = q0 / 64 + 4;
  u32x4 rk[1], rv[DV / 64]; float rc = 0.f; u32x2 rm = {0u, 0u};
  auto prefetch = [&](int kt) {
    const int kb = kt * 64;
    {
      const int row = tid >> 3, kc = tid & 7;
      rk[0] = *(const u32x4*)(p.PR + (size_t)(b * S + kb + row) * NPR + koff + kc * 8);
    }
#pragma unroll
    for (int i = 0; i < DV / 64; ++i) {
      const int c = tid + 512 * i, row = c >> 3, kc = c & 7;
      rv[i] = *(const u32x4*)(p.VT + ((size_t)(b * NV + vf0 + row)) * S + kb + kc * 8);
    }
    if (VAR == 1) { if (tid < 64) rc = p.CUM[(size_t)(b * 4 + hfox) * S + kb + tid]; }
    if (VAR == 3) rm = *(const u32x2*)(p.MASK + (size_t)(b * S + query) * 128 + kt * 2);
  };
  prefetch((VAR == 2) ? (nkt - 1) : 0);
  for (int it = 0; it < nkt; ++it) {
    const int kt = (VAR == 2) ? (nkt - 1 - it) : it;
    const int kb = kt * 64;
    __syncthreads();
    {
      const int row = tid >> 3, kc = tid & 7;
      *(u32x4*)(Kt + row * ROWB + kc * 16) = rk[0];
    }
#pragma unroll
    for (int i = 0; i < DV / 64; ++i) {
      const int c = tid + 512 * i, row = c >> 3, kc = c & 7;
      *(u32x4*)(Vt + row * ROWB + kc * 16) = rv[i];
    }
    if (VAR == 1) { if (tid < 64) cumt[tid] = rc * LOG2E; }
    const u32x2 mw = rm;
    __syncthreads();
    if (it + 1 < nkt) prefetch((VAR == 2) ? (kt - 1) : (kt + 1));
#pragma unroll
    for (int ss = 0; ss < 2; ++ss) {
      const int sub = (VAR == 2) ? 1 - ss : ss;
      const int kb2 = kb + sub * 32;
      if (kb2 > qw + 31) continue;
      f32x16 sacc = zero16();
#pragma unroll
      for (int ks = 0; ks < 4; ++ks) {
        bf16x8 a = *(const bf16x8*)(Kt + (sub * 32 + r) * ROWB + ks * 32 + hh * 16);
        sacc = mfma(a, qf[ks], sacc);
      }
      float pv[16];
      if (VAR != 2) {
        const unsigned w = sub ? mw[1] : mw[0];
        const f32x16 sc = sacc;
#pragma unroll
        for (int i = 0; i < 16; ++i) {
          float sv = sc[i];
          if (VAR == 1) sv += cq2 - cumt[sub * 32 + crow(i, hh)];
          pv[i] = sv;
        }
        if (VAR == 3) {
#pragma unroll
          for (int i = 0; i < 16; ++i) pv[i] = (((w >> crow(i, hh)) & 1u) != 0u) ? pv[i] : -INFINITY;
        } else if (kb2 + 31 > qw) {
#pragma unroll
          for (int i = 0; i < 16; ++i) pv[i] = (kb2 + crow(i, hh) <= query) ? pv[i] : -INFINITY;
        }
        float mx = pv[0];
#pragma unroll
        for (int i = 1; i < 16; ++i) mx = fmaxf(mx, pv[i]);
        mx = xmax32(mx);
        const float mn = fmaxf(m, mx);
        const float mu = (mn == -INFINITY) ? 0.f : mn;
        if (__any(mn != m)) {
          const float alpha = __builtin_amdgcn_exp2f(m - mu);
          l *= alpha;
#pragma unroll
          for (int db = 0; db < DV / 32; ++db) O[db] = O[db] * alpha;
          m = mn;
        }
        float ps = 0.f;
#pragma unroll
        for (int i = 0; i < 16; ++i) { pv[i] = __builtin_amdgcn_exp2f(pv[i] - mu); ps += pv[i]; }
        l += xsum32(ps);
      } else {
        float bt[16], om[16];
#pragma unroll
        for (int i = 0; i < 16; ++i) {
          const float zc = fmaxf(sacc[i], -115.f);
          const float e = __builtin_amdgcn_exp2f(-zc);
          const float bb = __builtin_amdgcn_rcpf(1.f + e);
          bt[i] = bb;
          om[i] = e * bb;
        }
        if (kb2 + 31 >= qw) {
#pragma unroll
          for (int i = 0; i < 16; ++i) {
            const bool strict = (kb2 + crow(i, hh)) < query;
            bt[i] = strict ? bt[i] : 0.f;
            om[i] = strict ? om[i] : 1.f;
          }
        }
        float go[4], gx[4];
#pragma unroll
        for (int mm = 0; mm < 4; ++mm) go[mm] = (om[4 * mm] * om[4 * mm + 1]) * (om[4 * mm + 2] * om[4 * mm + 3]);
#pragma unroll
        for (int mm = 0; mm < 4; ++mm) gx[mm] = xoth32(go[mm], hh);
        float tail = 1.f;
#pragma unroll
        for (int mm = 3; mm >= 0; --mm) {
          const float later = tail * (hh == 0 ? gx[mm] : 1.f);
          const float a3 = R * later;
          const float a2 = a3 * om[4 * mm + 3];
          const float a1 = a2 * om[4 * mm + 2];
          const float a0 = a1 * om[4 * mm + 1];
          pv[4 * mm + 3] = bt[4 * mm + 3] * a3;
          pv[4 * mm + 2] = bt[4 * mm + 2] * a2;
          pv[4 * mm + 1] = bt[4 * mm + 1] * a1;
          pv[4 * mm + 0] = bt[4 * mm + 0] * a0;
          tail *= go[mm] * gx[mm];
        }
        R *= tail;
      }
      bf16x8 pf[2];
#pragma unroll
      for (int s2 = 0; s2 < 2; ++s2) {
        u32x4 u;
#pragma unroll
        for (int j = 0; j < 4; ++j) u[j] = pk2(pv[8 * s2 + 2 * j], pv[8 * s2 + 2 * j + 1]);
        pf[s2] = __builtin_bit_cast(bf16x8, u);
      }
#pragma unroll
      for (int db = 0; db < DV / 32; ++db)
#pragma unroll
        for (int s2 = 0; s2 < 2; ++s2) {
          const char* vp = Vt + (db * 32 + r) * ROWB + (sub * 32 + 16 * s2 + 4 * hh) * 2;
          u32x2 lo = *(const u32x2*)vp, hi = *(const u32x2*)(vp + 16);
          u32x4 u; u[0] = lo[0]; u[1] = lo[1]; u[2] = hi[0]; u[3] = hi[1];
          O[db] = mfma(__builtin_bit_cast(bf16x8, u), pf[s2], O[db]);
        }
    }
  }
  lsum = l;
}

template <int DV>
DI void store_y(const P& p, int b, int q0, int ycol, const f32x16 (&O)[DV / 32]) {
  const int lane = TID() & 63, wave = TID() >> 6, r = lane & 31, hh = lane >> 5;
  const int token = b * S + q0 + wave * 32 + r;
#pragma unroll
  for (int db = 0; db < DV / 32; ++db)
#pragma unroll
    for (int g4 = 0; g4 < 4; ++g4) {
      u32x2 w; w[0] = pk2(O[db][4 * g4], O[db][4 * g4 + 1]); w[1] = pk2(O[db][4 * g4 + 2], O[db][4 * g4 + 3]);
      *(u32x2*)(p.Y + (size_t)token * NY + ycol + db * 32 + 8 * g4 + 4 * hh) = w;
    }
}

DI void attn_task_diff(const P& p, int l, int b, int h, int q0, char* lds) {
  const int lane = TID() & 63, hh = lane >> 5;
  const float* lq1 = p.in[8] + l * 64; const float* lk1 = p.in[9] + l * 64;
  const float* lq2 = p.in[10] + l * 64; const float* lk2 = p.in[11] + l * 64;
  float d1 = 0.f, d2 = 0.f;
  for (int i = 0; i < 64; ++i) { d1 += lq1[i] * lk1[i]; d2 += lq2[i] * lk2[i]; }
  const float lam_init = 0.8f - 0.6f * expf(-0.3f * (float)l);
  const float lam = expf(d1) - expf(d2) + lam_init;
  f32x16 O1[4], O2[4]; float l1, l2;
  attn_core<0, 128>(p, b, q0, AQ + h * 128, AK + h * 128, h * 128, 0, lds, O1, l1);
  const float i1 = 1.f / l1;
#pragma unroll
  for (int db = 0; db < 4; ++db)
#pragma unroll
    for (int i = 0; i < 16; ++i) O1[db][i] *= i1;
  attn_core<0, 128>(p, b, q0, AQ + h * 128 + 64, AK + h * 128 + 64, h * 128, 0, lds, O2, l2);
  const float i2 = lam / l2;
  float ss = 0.f;
#pragma unroll
  for (int db = 0; db < 4; ++db)
#pragma unroll
    for (int i = 0; i < 16; ++i) { const float v = O1[db][i] - i2 * O2[db][i]; O1[db][i] = v; ss += v * v; }
  ss = xsum32(ss);
  const float rs = rsqrtf(ss * (1.f / 128.f) + 1e-5f) * (1.f - lam_init);
  const float* dg = p.in[12] + l * 128;
#pragma unroll
  for (int db = 0; db < 4; ++db)
#pragma unroll
    for (int i = 0; i < 16; ++i) O1[db][i] *= rs * dg[db * 32 + crow(i, hh)];
  store_y<128>(p, b, q0, h * 128, O1);
}
template <int VAR>
DI void attn_task_64(const P& p, int b, int h, int q0, char* lds) {
  f32x16 O[2]; float ls;
  constexpr int qo = (VAR == 1) ? BQ : (VAR == 2 ? CQ : DQ);
  constexpr int ko = (VAR == 1) ? BKo : (VAR == 2 ? CK : DK);
  constexpr int vo = (VAR == 1) ? 512 : (VAR == 2 ? 768 : 1024);
  attn_core<VAR, 64>(p, b, q0, qo + h * 64, ko + h * 64, vo + h * 64, h, lds, O, ls);
  if (VAR != 2) {
    const float il = 1.f / ls;
#pragma unroll
    for (int db = 0; db < 2; ++db)
#pragma unroll
      for (int i = 0; i < 16; ++i) O[db][i] *= il;
  }
  store_y<64>(p, b, q0, vo + h * 64, O);
}

DI void idx_task(const P& p, int b, int t0, char* lds) {
  float* sc = (float*)lds;
  const int tid = TID(), lane = tid & 63, wave = tid >> 6, r = lane & 31, hh = lane >> 5;
  __syncthreads();
  bf16x8 afA[4], afB[4];
  {
    const u16* ap = p.PR + (size_t)(b * S + t0 + (r >> 3)) * NPR + IQ + (r & 7) * 64;
#pragma unroll
    for (int ks = 0; ks < 4; ++ks) { afA[ks] = *(const bf16x8*)(ap + ks * 16 + hh * 8); afB[ks] = *(const bf16x8*)(ap + (size_t)4 * NPR + ks * 16 + hh * 8); }
  }
  float iwA[16], iwB[16];
#pragma unroll
  for (int i = 0; i < 16; ++i) {
    iwA[i] = p.IW[(size_t)(b * S + t0 + (i >> 2)) * 8 + (i & 3) + 4 * hh];
    iwB[i] = p.IW[(size_t)(b * S + t0 + 4 + (i >> 2)) * 8 + (i & 3) + 4 * hh];
  }
  const int ntile = (t0 + 7) / 32 + 1;
  for (int tb = wave * 4; tb < ntile; tb += 32) {
    bf16x8 bb[4][4];
#pragma unroll
    for (int u = 0; u < 4; ++u) {
      const int tile = min(tb + u, ntile - 1);
      const u16* bp = p.PR + (size_t)(b * S + tile * 32 + r) * NPR + IK;
#pragma unroll
      for (int ks = 0; ks < 4; ++ks) bb[u][ks] = *(const bf16x8*)(bp + ks * 16 + hh * 8);
    }
#pragma unroll
    for (int u = 0; u < 4; ++u) {
      const int tile = tb + u;
      f32x16 accA = zero16(), accB = zero16();
#pragma unroll
      for (int ks = 0; ks < 4; ++ks) { accA = mfma(afA[ks], bb[u][ks], accA); accB = mfma(afB[ks], bb[u][ks], accB); }
      float sA[4], sB[4];
#pragma unroll
      for (int q = 0; q < 4; ++q) {
        float va = 0.f, vb = 0.f;
#pragma unroll
        for (int j = 0; j < 4; ++j) { va += fmaxf(accA[4 * q + j], 0.f) * iwA[4 * q + j]; vb += fmaxf(accB[4 * q + j], 0.f) * iwB[4 * q + j]; }
        sA[q] = xsum32(va); sB[q] = xsum32(vb);
      }
      if (tile < ntile) {
        sc[(2 * hh) * 4096 + tile * 32 + r] = hh ? sA[2] : sA[0];
        sc[(2 * hh + 1) * 4096 + tile * 32 + r] = hh ? sA[3] : sA[1];
        sc[(4 + 2 * hh) * 4096 + tile * 32 + r] = hh ? sB[2] : sB[0];
        sc[(5 + 2 * hh) * 4096 + tile * 32 + r] = hh ? sB[3] : sB[1];
      }
    }
  }
  __syncthreads();
  const int t = __builtin_amdgcn_readfirstlane(t0 + wave);
  unsigned key[64];
#pragma unroll
  for (int c = 0; c < 64; ++c) {
    const int s = c * 64 + lane;
    unsigned u = __float_as_uint(sc[wave * 4096 + s]);
    u = (u & 0x80000000u) ? ~u : (u | 0x80000000u);
    key[c] = (s <= t) ? u : 0u;
  }
  u64 mymask = 0;
  const int nch = (t >> 6) + 1;
  if (t >= 256) {
    unsigned T = 0;
    for (int bit = 31; bit >= 0; --bit) {
      const unsigned cand = T | (1u << bit);
      int cl = 0;
#pragma unroll
      for (int g = 0; g < 8; ++g) {
        if (g * 8 < nch) {
#pragma unroll
          for (int c = g * 8; c < g * 8 + 8; ++c) cl += (key[c] >= cand) ? 1 : 0;
        }
      }
      int cnt = 0;
#pragma unroll
      for (int k2 = 0; k2 < 7; ++k2) cnt += __popcll(__ballot(((cl >> k2) & 1) != 0)) << k2;
      if (cnt >= 256) T = cand;
      if (cnt == 256) break;
    }
    int ngt = 0;
#pragma unroll
    for (int c = 0; c < 64; ++c) ngt += __popcll(__ballot(key[c] > T));
    int rem = 256 - ngt;
#pragma unroll
    for (int c = 0; c < 64; ++c) {
      const u64 gt = __ballot(key[c] > T);
      u64 eq = __ballot(key[c] == T);
      int e = __popcll(eq);
      while (e > rem) { eq &= ~(1ull << (63 - __clzll(eq))); --e; }
      rem -= e;
      const u64 mk = gt | eq;
      if (lane == c) mymask = mk;
    }
  } else {
#pragma unroll
    for (int c = 0; c < 64; ++c) {
      const u64 mk = __ballot(c * 64 + lane <= t);
      if (lane == c) mymask = mk;
    }
  }
  *(u64*)(p.MASK + (size_t)(b * S + t) * 128 + lane * 2) = mymask;
}

DI void scan_task(const P& p, int pair) {
  const int lane = TID() & 63;
  const int b = pair >> 2, h = pair & 3;
  const float* src = p.FL + ((size_t)(b * S + lane * 64)) * 4 + h;
  float v[64];
#pragma unroll
  for (int j = 0; j < 64; ++j) v[j] = src[j * 4];
#pragma unroll
  for (int j = 1; j < 64; ++j) v[j] += v[j - 1];
  float tot = v[63], inc = tot;
#pragma unroll
  for (int o = 1; o < 64; o <<= 1) { const float u = __shfl_up(inc, o); if (lane >= o) inc += u; }
  const float off = inc - tot;
  float* dst = p.CUM + (size_t)pair * S + lane * 64;
#pragma unroll
  for (int j = 0; j < 64; j += 4) {
    f32x4 o4; o4[0] = v[j] + off; o4[1] = v[j + 1] + off; o4[2] = v[j + 2] + off; o4[3] = v[j + 3] + off;
    *(f32x4*)(dst + j) = o4;
  }
}

DI int zz_id(int r) { const int G = gridDim.x, bb = blockIdx.x; return r * G + ((r & 1) ? (G - 1 - bb) : bb); }
DI bool attn_map(int r, int& bh, int& qt) {
  if (gridDim.x == 256) {
    if (r >= 2) return false;
    const int x = blockIdx.x & 7, jb = blockIdx.x >> 3;
    bh = 4 * x + (jb >> 3);
    qt = (r == 0) ? 15 - (jb & 7) : (jb & 7);
    return true;
  }
  if (r * (int)gridDim.x >= 512) return false;
  const int id = zz_id(r);
  if (id >= 512) { bh = -1; return true; }
  bh = id & 31; qt = 15 - (id >> 5);
  return true;
}
DI void phase_mix1(const P& p, int l, char* lds) {
  for (int task = blockIdx.x; task < 4; task += gridDim.x) scan_task(p, task * 8 + (TID() >> 6));
  for (int r = 0; r * (int)gridDim.x < 4096; ++r) {
    const int id = zz_id(r); if (id >= 4096) continue;
    const int trev = id >> 3, b = id & 7;
    idx_task(p, b, (511 - trev) * 8, lds);
  }
  int bh, qt;
  for (int r = 0; attn_map(r, bh, qt); ++r) { if (bh >= 0) attn_task_diff(p, l, bh >> 2, bh & 3, qt * 256, lds); }
  for (int r = 0; attn_map(r, bh, qt); ++r) { if (bh >= 0) attn_task_64<2>(p, bh >> 2, bh & 3, qt * 256, lds); }
}
DI void phase_mix2(const P& p, char* lds) {
  int bh, qt;
  for (int r = 0; attn_map(r, bh, qt); ++r) { if (bh >= 0) attn_task_64<1>(p, bh >> 2, bh & 3, qt * 256, lds); }
  for (int r = 0; attn_map(r, bh, qt); ++r) { if (bh >= 0) attn_task_64<3>(p, bh >> 2, bh & 3, qt * 256, lds); }
}

__global__ void __launch_bounds__(512, 2) mega_kernel(P p) {
  __shared__ __attribute__((aligned(16))) char lds[LDS_BYTES];
  cg::grid_group grid = cg::this_grid();
  u16* act = p.PR; u16* merged = p.PR;
  for (int l = 0; l < 2; ++l) {
    const float* xcur = (l == 0) ? p.in[0] : p.xres;
    phase_conv(p, l, lds); phase_norm(xcur, p.in[2] + l * D, p.hb); grid.sync();
    phase_gu(p, p.Wt + OFF_GU1, act, lds); grid.sync();
    phase_resid(p.Wt + OFF_DN1, act, DFF, xcur, p.xres, 0.5f, lds); grid.sync();
    phase_norm(p.xres, p.in[5] + l * D, p.hb); grid.sync();
    phase_proj(p, l, lds); grid.sync();
    phase_mix1(p, l, lds); grid.sync();
    phase_mix2(p, lds); grid.sync();
    phase_merge(p, l, merged, lds); grid.sync();
    phase_resid(p.Wt + OFF_OUT, merged, D, p.xres, p.xres, 1.0f, lds); grid.sync();
    phase_norm(p.xres, p.in[20] + l * D, p.hb); grid.sync();
    phase_gu(p, p.Wt + OFF_GU2, act, lds); grid.sync();
    phase_resid(p.Wt + OFF_DN2, act, DFF, p.xres, p.xres, 0.5f, lds); grid.sync();
  }
  phase_final_norm(p.xres, p.in[23]);
}

extern "C" void kernel_launch(void* const* d_in, const int* in_sizes, int n_in, void* d_out, int out_size, void* d_ws, size_t ws_size, hipStream_t stream) {
  P p{};
  for (int i = 0; i < 24; ++i) p.in[i] = (const float*)d_in[i];
  p.pos = (const int*)d_in[1];
  p.xres = (float*)d_out;
  char* w = (char*)d_ws; size_t off = 0;
  auto take = [&](size_t bytes) { char* r = w + off; off += (bytes + 255) & ~(size_t)255; return r; };
  p.Wt = (u16*)take(WT_ELEMS * 2);
  p.hb = (u16*)take((size_t)M * D * 2);
  p.PR = (u16*)take((size_t)M * NPR * 2);
  p.VT = (u16*)take((size_t)NB * NV * S * 2);
  p.Y = (u16*)take((size_t)M * NY * 2);
  p.MASK = (unsigned*)take((size_t)M * 128 * 4);
  p.FL = (float*)take((size_t)M * 4 * 4);
  p.IW = (float*)take((size_t)M * 8 * 4);
  p.CUM = (float*)take((size_t)M * 4 * 4);
  p.COS = (float*)take((size_t)S * 8 * 4);
  p.SIN = (float*)take((size_t)S * 8 * 4);
  if (off > ws_size) { fprintf(stderr, "workspace too small: need %zu have %zu\n", off, ws_size); return; }
  static int grid_blocks = 0;
  if (!grid_blocks) {
    int dev = 0, cus = 0, per_cu = 0;
    hipGetDevice(&dev);
    hipDeviceGetAttribute(&cus, hipDeviceAttributeMultiprocessorCount, dev);
    hipOccupancyMaxActiveBlocksPerMultiprocessor(&per_cu, mega_kernel, 512, 0);
    grid_blocks = cus * (per_cu < 1 ? 1 : per_cu);
  }
  void* args[] = {&p};
  hipError_t e = hipLaunchCooperativeKernel((void*)mega_kernel, dim3(grid_blocks), dim3(512), args, 0, stream);
  if (e != hipSuccess) fprintf(stderr, "cooperative launch failed: %s (grid %d)\n", hipGetErrorString(e), grid_blocks);
}
```

```cpp
#include <hip/hip_runtime.h>
#include <hip/hip_cooperative_groups.h>
#include <cstdio>
namespace cg = cooperative_groups;

#define DI __device__ __forceinline__
typedef unsigned short u16;
typedef unsigned long long u64;
typedef __attribute__((ext_vector_type(8))) short bf16x8;
typedef __attribute__((ext_vector_type(16))) float f32x16;
typedef __attribute__((ext_vector_type(4))) float f32x4;
typedef __attribute__((ext_vector_type(2))) float f32x2;
typedef __attribute__((ext_vector_type(2))) __bf16 bf2;
typedef __attribute__((ext_vector_type(4))) unsigned u32x4;
typedef __attribute__((ext_vector_type(2))) unsigned u32x2;

constexpr int D = 1024, NB = 8, S = 4096, M = NB * S, DFF = 2816;
constexpr int NPR = 3200, NV = 1280, NY = 1280;
constexpr int AQ = 0, AK = 512, BQ = 1024, BKo = 1280, CQ = 1536, CK = 1792, DQ = 2048, DK = 2304, IQ = 2560, IK = 3072, SMALL = 3136;
constexpr size_t OFF_GU1 = 0;
constexpr size_t OFF_DN1 = OFF_GU1 + (size_t)5632 * 1024;
constexpr size_t OFF_IN = OFF_DN1 + (size_t)1024 * 2816;
constexpr size_t OFF_GATE = OFF_IN + (size_t)4608 * 1024;
constexpr size_t OFF_BRA = OFF_GATE + (size_t)4096 * 1024;
constexpr size_t OFF_BRB = OFF_BRA + (size_t)1024 * 512;
constexpr size_t OFF_BRC = OFF_BRB + (size_t)1024 * 256;
constexpr size_t OFF_BRD = OFF_BRC + (size_t)1024 * 256;
constexpr size_t OFF_OUT = OFF_BRD + (size_t)1024 * 256;
constexpr size_t OFF_GU2 = OFF_OUT + (size_t)1024 * 1024;
constexpr size_t OFF_DN2 = OFF_GU2 + (size_t)5632 * 1024;
constexpr size_t WT_ELEMS = OFF_DN2 + (size_t)1024 * 2816;

constexpr float LOG2E = 1.4426950408889634f;
constexpr int LDS_BYTES = 131072;
constexpr int ROWB = 144;

struct P {
  const float* in[24];
  const int* pos;
  float* xres;
  u16* Wt; u16* hb; u16* PR; u16* VT; u16* Y;
  unsigned* MASK; float* FL; float* IW; float* CUM; float* COS; float* SIN;
};

DI int TID() { int t = (int)__builtin_amdgcn_workitem_id_x(); asm volatile("" : "+v"(t)); return t; }
DI unsigned pk2(float a, float b) { f32x2 v = {a, b}; bf2 r = __builtin_convertvector(v, bf2); return __builtin_bit_cast(unsigned, r); }
DI u16 f2bf(float a) { __bf16 h = (__bf16)a; return __builtin_bit_cast(u16, h); }
DI float wsum(float v) {
#pragma unroll
  for (int o = 32; o > 0; o >>= 1) v += __shfl_xor(v, o);
  return v;
}
DI float xmax32(float x) { auto r2 = __builtin_amdgcn_permlane32_swap(__float_as_uint(x), __float_as_uint(x), false, false); return fmaxf(__uint_as_float(r2[0]), __uint_as_float(r2[1])); }
DI float xsum32(float x) { auto r2 = __builtin_amdgcn_permlane32_swap(__float_as_uint(x), __float_as_uint(x), false, false); return __uint_as_float(r2[0]) + __uint_as_float(r2[1]); }
DI float xoth32(float x, int hh) { auto r2 = __builtin_amdgcn_permlane32_swap(__float_as_uint(x), __float_as_uint(x), false, false); return __uint_as_float(hh ? r2[0] : r2[1]); }
DI constexpr int crow(int i, int hh) { return (i & 3) + 8 * (i >> 2) + 4 * hh; }
DI f32x16 mfma(bf16x8 a, bf16x8 b, f32x16 c) { return __builtin_amdgcn_mfma_f32_32x32x16_bf16(a, b, c, 0, 0, 0); }
DI f32x16 zero16() { f32x16 z;
#pragma unroll
  for (int i = 0; i < 16; ++i) z[i] = 0.f; return z; }

DI void phase_norm(const float* __restrict__ src, const float* __restrict__ g, u16* __restrict__ dst) {
  const int lane = TID() & 63;
  const int wave = (blockIdx.x * 512 + TID()) >> 6, nw = gridDim.x * 8;
  for (int row = wave; row < M; row += nw) {
    const f32x4* p = (const f32x4*)(src + (size_t)row * D);
    f32x4 v[4]; float ss = 0.f;
#pragma unroll
    for (int j = 0; j < 4; ++j) { v[j] = p[lane + 64 * j]; ss += v[j][0] * v[j][0] + v[j][1] * v[j][1] + v[j][2] * v[j][2] + v[j][3] * v[j][3]; }
    ss = wsum(ss);
    const float rs = rsqrtf(ss * (1.f / D) + 1e-6f);
#pragma unroll
    for (int j = 0; j < 4; ++j) {
      f32x4 gg = ((const f32x4*)g)[lane + 64 * j];
      u32x2 o; o[0] = pk2(v[j][0] * rs * gg[0], v[j][1] * rs * gg[1]); o[1] = pk2(v[j][2] * rs * gg[2], v[j][3] * rs * gg[3]);
      *(u32x2*)(dst + (size_t)row * D + (lane + 64 * j) * 4) = o;
    }
  }
}
DI void phase_final_norm(float* __restrict__ x, const float* __restrict__ g) {
  const int lane = TID() & 63;
  const int wave = (blockIdx.x * 512 + TID()) >> 6, nw = gridDim.x * 8;
  for (int row = wave; row < M; row += nw) {
    f32x4* p = (f32x4*)(x + (size_t)row * D);
    f32x4 v[4]; float ss = 0.f;
#pragma unroll
    for (int j = 0; j < 4; ++j) { v[j] = p[lane + 64 * j]; ss += v[j][0] * v[j][0] + v[j][1] * v[j][1] + v[j][2] * v[j][2] + v[j][3] * v[j][3]; }
    ss = wsum(ss);
    const float rs = rsqrtf(ss * (1.f / D) + 1e-6f);
#pragma unroll
    for (int j = 0; j < 4; ++j) {
      f32x4 gg = ((const f32x4*)g)[lane + 64 * j];
      f32x4 o; o[0] = v[j][0] * rs * gg[0]; o[1] = v[j][1] * rs * gg[1]; o[2] = v[j][2] * rs * gg[2]; o[3] = v[j][3] * rs * gg[3];
      p[lane + 64 * j] = o;
    }
  }
}

DI int map_gu(int n) { int c = (n < DFF) ? n : n - DFF; return (c >> 5) * 64 + (c & 31) + ((n < DFF) ? 0 : 32); }
DI int map_in(int n) {
  if (n < 512) return n;
  if (n < 1024) return n;
  if (n < 1536) return n - 1024 + 3200;
  if (n < 1792) return n - 1536 + BQ;
  if (n < 2048) return n - 1792 + BKo;
  if (n < 2304) return n - 2048 + 3200 + 512;
  if (n < 2308) return n - 2304 + SMALL;
  if (n < 2564) return n - 2308 + CQ;
  if (n < 2820) return n - 2564 + CK;
  if (n < 3076) return n - 2820 + 3200 + 768;
  if (n < 3332) return n - 3076 + DQ;
  if (n < 3588) return n - 3332 + DK;
  if (n < 3844) return n - 3588 + 3200 + 1024;
  if (n < 4356) return n - 3844 + IQ;
  if (n < 4420) return n - 4356 + IK;
  return n - 4420 + SMALL + 4;
}
DI void conv_w(const float* __restrict__ W, int K, int N, u16* __restrict__ Wt, int mp, char* lds) {
  const int tid = TID(), half = tid >> 8, t8 = tid & 255, tn = t8 & 15, tk = t8 >> 4;
  char* my = lds + half * (64 * ROWB);
  const int ntn = (N + 63) >> 6, ntk = K >> 6, ntile = ntn * ntk;
  for (int base = 2 * blockIdx.x; base < ntile; base += 2 * gridDim.x) {
    const int tile = base + half;
    const bool on = tile < ntile;
    const int n0 = (tile % ntn) * 64, k0 = (tile / ntn) * 64;
    f32x4 v[4];
    const int n = n0 + 4 * tn;
#pragma unroll
    for (int i = 0; i < 4; ++i) {
      if (on && n < N) v[i] = *(const f32x4*)(W + (size_t)(k0 + 4 * tk + i) * N + n);
      else { v[i][0] = 0.f; v[i][1] = 0.f; v[i][2] = 0.f; v[i][3] = 0.f; }
    }
    __syncthreads();
#pragma unroll
    for (int j = 0; j < 4; ++j) {
      u32x2 w; w[0] = pk2(v[0][j], v[1][j]); w[1] = pk2(v[2][j], v[3][j]);
      *(u32x2*)(my + (4 * tn + j) * ROWB + tk * 8) = w;
    }
    __syncthreads();
#pragma unroll
    for (int ps = 0; ps < 2; ++ps) {
      const int nn = (t8 >> 3) + 32 * ps, c = t8 & 7, ng = n0 + nn;
      if (on && ng < N) {
        const int np = (mp == 0) ? ng : (mp == 1 ? map_gu(ng) : map_in(ng));
        *(u32x4*)(Wt + (size_t)np * K + k0 + 8 * c) = *(const u32x4*)(my + nn * ROWB + c * 16);
      }
    }
  }
}
DI void phase_conv(const P& p, int l, char* lds) {
  conv_w(p.in[3] + (size_t)l * 1024 * 5632, 1024, 5632, p.Wt + OFF_GU1, 1, lds);
  conv_w(p.in[4] + (size_t)l * 2816 * 1024, 2816, 1024, p.Wt + OFF_DN1, 0, lds);
  conv_w(p.in[6] + (size_t)l * 1024 * 4428, 1024, 4428, p.Wt + OFF_IN, 2, lds);
  conv_w(p.in[13] + (size_t)l * 1024 * 4096, 1024, 4096, p.Wt + OFF_GATE, 0, lds);
  conv_w(p.in[15] + (size_t)l * 512 * 1024, 512, 1024, p.Wt + OFF_BRA, 0, lds);
  conv_w(p.in[16] + (size_t)l * 256 * 1024, 256, 1024, p.Wt + OFF_BRB, 0, lds);
  conv_w(p.in[17] + (size_t)l * 256 * 1024, 256, 1024, p.Wt + OFF_BRC, 0, lds);
  conv_w(p.in[18] + (size_t)l * 256 * 1024, 256, 1024, p.Wt + OFF_BRD, 0, lds);
  conv_w(p.in[19] + (size_t)l * 1024 * 1024, 1024, 1024, p.Wt + OFF_OUT, 0, lds);
  conv_w(p.in[21] + (size_t)l * 1024 * 5632, 1024, 5632, p.Wt + OFF_GU2, 1, lds);
  conv_w(p.in[22] + (size_t)l * 2816 * 1024, 2816, 1024, p.Wt + OFF_DN2, 0, lds);
  const int gt = blockIdx.x * 512 + TID(), nt = gridDim.x * 512;
  for (int i = gt; i < 52 * 1024; i += nt) p.Wt[OFF_IN + (size_t)3148 * 1024 + i] = 0;
  for (int i = gt; i < 128 * 1024; i += nt) p.Wt[OFF_IN + (size_t)4480 * 1024 + i] = 0;
  if (l == 0) {
    for (int i = gt; i < S * 8; i += nt) {
      const int s = i >> 3, c = i & 7;
      const float freq = powf(500000.0f, -(float)(2 * c) / 16.0f);
      const float ang = (float)p.pos[s] * freq;
      p.COS[i] = cosf(ang); p.SIN[i] = sinf(ang);
    }
  }
}

#define LAS __attribute__((address_space(3)))
template <int WF, int WT, int WGT, int PF = 1>
DI void gemm_loop(const u16* __restrict__ A, size_t lda, const u16* __restrict__ B, size_t ldb, int K, f32x16 (&acc)[WF][WT], char* lds) {
  constexpr int WGF = 8 / WGT;
  constexpr int BF = 32 * WF * WGF, BT = 32 * WT * WGT;
  constexpr int ABYTES = BF * 128, BBYTES = BT * 128, STAGE = ABYTES + BBYTES;
  constexpr int IA = BF / 64, IB = BT / 64;
  static_assert(2 * STAGE <= LDS_BYTES, "lds");
  const int tid = TID(), lane = tid & 63, wave = tid >> 6;
  const int wf = wave / WGT, wt = wave % WGT, r = lane & 31, hh = lane >> 5;
  const int kcs = (tid & 7) ^ ((tid >> 4) & 7);
  const u16* ga = A + (size_t)(tid >> 3) * lda + kcs * 8;
  const u16* gb = B + (size_t)(tid >> 3) * ldb + kcs * 8;
  LAS char* l3 = (LAS char*)lds;
  const int sw = (r >> 1) & 7;
  __syncthreads();
#pragma unroll
  for (int i = 0; i < IA; ++i) __builtin_amdgcn_global_load_lds((const unsigned*)(ga + (size_t)i * 64 * lda), (LAS unsigned*)(l3 + i * 8192 + wave * 1024), 16, 0, 0);
#pragma unroll
  for (int i = 0; i < IB; ++i) __builtin_amdgcn_global_load_lds((const unsigned*)(gb + (size_t)i * 64 * ldb), (LAS unsigned*)(l3 + ABYTES + i * 8192 + wave * 1024), 16, 0, 0);
  const int nk = K >> 6;
  for (int kt = 0; kt < nk; ++kt) {
    __syncthreads();
    if (kt + 1 < nk) {
      const int nb = ((kt + 1) & 1) * STAGE, k0 = (kt + 1) * 64;
#pragma unroll
      for (int i = 0; i < IA; ++i) __builtin_amdgcn_global_load_lds((const unsigned*)(ga + (size_t)i * 64 * lda + k0), (LAS unsigned*)(l3 + nb + i * 8192 + wave * 1024), 16, 0, 0);
#pragma unroll
      for (int i = 0; i < IB; ++i) __builtin_amdgcn_global_load_lds((const unsigned*)(gb + (size_t)i * 64 * ldb + k0), (LAS unsigned*)(l3 + nb + ABYTES + i * 8192 + wave * 1024), 16, 0, 0);
    }
    const char* sa = lds + (kt & 1) * STAGE;
    const char* sb = sa + ABYTES;
    bf16x8 af[PF + 1][WF], bfr[PF + 1][WT];
    if (PF) {
      const int co = ((0 * 2 + hh) ^ sw) << 4;
#pragma unroll
      for (int f = 0; f < WF; ++f) af[0][f] = *(const bf16x8*)(sa + ((wf * WF + f) * 32 + r) * 128 + co);
#pragma unroll
      for (int t = 0; t < WT; ++t) bfr[0][t] = *(const bf16x8*)(sb + ((wt * WT + t) * 32 + r) * 128 + co);
    }
#pragma unroll
    for (int ks = 0; ks < 4; ++ks) {
      const int ld = PF ? ks + 1 : ks, li = PF ? ((ks + 1) & 1) : 0, ci = PF ? (ks & 1) : 0;
      if (ld < 4) {
        const int co = ((ld * 2 + hh) ^ sw) << 4;
#pragma unroll
        for (int f = 0; f < WF; ++f) af[li][f] = *(const bf16x8*)(sa + ((wf * WF + f) * 32 + r) * 128 + co);
#pragma unroll
        for (int t = 0; t < WT; ++t) bfr[li][t] = *(const bf16x8*)(sb + ((wt * WT + t) * 32 + r) * 128 + co);
      }
#pragma unroll
      for (int f = 0; f < WF; ++f)
#pragma unroll
        for (int t = 0; t < WT; ++t) acc[f][t] = mfma(af[ci][f], bfr[ci][t], acc[f][t]);
    }
    __syncthreads();
  }
}
DI bool tile_at(int round, int NF, int ntiles, int& ft, int& tt) {
  const int G8 = gridDim.x >> 3;
  const int L = (round * 8 + (int)(blockIdx.x & 7)) * G8 + (int)(blockIdx.x >> 3);
  if (L >= ntiles) return false;
  const int tg = L / (NF * 8), rem = L - tg * NF * 8;
  ft = rem >> 3; tt = tg * 8 + (rem & 7);
  return true;
}

DI void phase_gu(const P& p, const u16* __restrict__ Wt, u16* __restrict__ act, char* lds) {
  const int lane = TID() & 63, wave = TID() >> 6, wf = wave >> 2, wt = wave & 3, r = lane & 31, hh = lane >> 5;
  for (int rnd = 0; rnd * (int)gridDim.x < 22 * 128; ++rnd) {
    int ft, tt; if (!tile_at(rnd, 22, 22 * 128, ft, tt)) continue;
    f32x16 acc[4][2];
#pragma unroll
    for (int f = 0; f < 4; ++f)
#pragma unroll
      for (int t = 0; t < 2; ++t) acc[f][t] = zero16();
    gemm_loop<4, 2, 4>(Wt + (size_t)ft * 256 * 1024, 1024, p.hb + (size_t)tt * 256 * 1024, 1024, 1024, acc, lds);
#pragma unroll
    for (int t = 0; t < 2; ++t) {
      const int token = tt * 256 + (wt * 2 + t) * 32 + r;
#pragma unroll
      for (int pr = 0; pr < 2; ++pr) {
        const int c0 = ft * 128 + wf * 64 + pr * 32;
#pragma unroll
        for (int g4 = 0; g4 < 4; ++g4) {
          float o[4];
#pragma unroll
          for (int j = 0; j < 4; ++j) { const float g = acc[2 * pr][t][4 * g4 + j], u = acc[2 * pr + 1][t][4 * g4 + j]; o[j] = g * __builtin_amdgcn_rcpf(1.f + __builtin_amdgcn_exp2f(-LOG2E * g)) * u; }
          u32x2 w; w[0] = pk2(o[0], o[1]); w[1] = pk2(o[2], o[3]);
          *(u32x2*)(act + (size_t)token * DFF + c0 + 8 * g4 + 4 * hh) = w;
        }
      }
    }
  }
}
DI void phase_resid(const u16* __restrict__ Wt, const u16* __restrict__ B, int K, const float* __restrict__ xsrc, float* __restrict__ xout, float alpha, char* lds) {
  const int lane = TID() & 63, wave = TID() >> 6, wf = wave >> 2, wt = wave & 3, r = lane & 31, hh = lane >> 5;
  for (int rnd = 0; rnd * (int)gridDim.x < 4 * 128; ++rnd) {
    int ft, tt; if (!tile_at(rnd, 4, 4 * 128, ft, tt)) continue;
    f32x16 acc[4][2];
#pragma unroll
    for (int f = 0; f < 4; ++f)
#pragma unroll
      for (int t = 0; t < 2; ++t) acc[f][t] = zero16();
    gemm_loop<4, 2, 4>(Wt + (size_t)ft * 256 * K, K, B + (size_t)tt * 256 * K, K, K, acc, lds);
#pragma unroll
    for (int f = 0; f < 4; ++f)
#pragma unroll
      for (int t = 0; t < 2; ++t) {
        const int token = tt * 256 + (wt * 2 + t) * 32 + r;
        const int fb = ft * 256 + (wf * 4 + f) * 32;
#pragma unroll
        for (int g4 = 0; g4 < 4; ++g4) {
          const size_t off = (size_t)token * D + fb + 8 * g4 + 4 * hh;
          f32x4 xv = *(const f32x4*)(xsrc + off);
#pragma unroll
          for (int j = 0; j < 4; ++j) xv[j] += alpha * acc[f][t][4 * g4 + j];
          *(f32x4*)(xout + off) = xv;
        }
      }
  }
}
DI void phase_proj(const P& p, int l, char* lds) {
  const int lane = TID() & 63, wave = TID() >> 6, wf = wave >> 2, wt = wave & 3, r = lane & 31, hh = lane >> 5;
  const float* bf = p.in[7] + l * 4;
  for (int rnd = 0; rnd * (int)gridDim.x < 18 * 128; ++rnd) {
    int ft, tt; if (!tile_at(rnd, 18, 18 * 128, ft, tt)) continue;
    f32x16 acc[4][2];
#pragma unroll
    for (int f = 0; f < 4; ++f)
#pragma unroll
      for (int t = 0; t < 2; ++t) acc[f][t] = zero16();
    gemm_loop<4, 2, 4>(p.Wt + OFF_IN + (size_t)ft * 256 * 1024, 1024, p.hb + (size_t)tt * 256 * 1024, 1024, 1024, acc, lds);
#pragma unroll
    for (int f = 0; f < 4; ++f)
#pragma unroll
      for (int t = 0; t < 2; ++t) {
        const int token = tt * 256 + (wt * 2 + t) * 32 + r;
        const int fb = ft * 256 + (wf * 4 + f) * 32;
        const int sidx = token & (S - 1), b = token >> 12;
        if (fb < 3200) {
          const bool rope = ((fb & 63) == 0) && (fb < 1024 || (fb >= 2048 && fb < SMALL));
          if (rope) {
            const f32x4 cs = *(const f32x4*)(p.COS + sidx * 8 + 4 * hh);
            const f32x4 sn = *(const f32x4*)(p.SIN + sidx * 8 + 4 * hh);
#pragma unroll
            for (int j = 0; j < 4; ++j) {
              const float x1 = acc[f][t][j], x2 = acc[f][t][4 + j];
              acc[f][t][j] = x1 * cs[j] - x2 * sn[j];
              acc[f][t][4 + j] = x2 * cs[j] + x1 * sn[j];
            }
          }
          const bool isq = (fb < 512) || (fb >= BQ && fb < BKo) || (fb >= CQ && fb < CK) || (fb >= DQ && fb < DK);
          if (isq) acc[f][t] = acc[f][t] * (0.125f * LOG2E);
          if (fb == SMALL) {
            if (hh == 0) {
#pragma unroll
              for (int j = 0; j < 4; ++j) {
                const float z = acc[f][t][j] + bf[j];
                p.FL[(size_t)token * 4 + j] = fminf(z, 0.f) - __logf(1.f + __expf(-fabsf(z)));
                p.IW[(size_t)token * 8 + 4 + j] = acc[f][t][4 + j];
              }
            } else {
#pragma unroll
              for (int j = 0; j < 4; ++j) p.IW[(size_t)token * 8 + j] = acc[f][t][j];
            }
          }
#pragma unroll
          for (int g4 = 0; g4 < 4; ++g4) {
            u32x2 w; w[0] = pk2(acc[f][t][4 * g4], acc[f][t][4 * g4 + 1]); w[1] = pk2(acc[f][t][4 * g4 + 2], acc[f][t][4 * g4 + 3]);
            *(u32x2*)(p.PR + (size_t)token * NPR + fb + 8 * g4 + 4 * hh) = w;
          }
        } else if (fb < 4480) {
          const int vf0 = fb - 3200;
#pragma unroll
          for (int i = 0; i < 16; ++i) p.VT[((size_t)(b * NV + vf0 + crow(i, hh))) * S + sidx] = f2bf(acc[f][t][i]);
        }
      }
  }
}
DI void phase_merge(const P& p, int l, u16* __restrict__ merged, char* lds) {
  const int lane = TID() & 63, wave = TID() >> 6, wf = wave >> 2, wt = wave & 3, r = lane & 31, hh = lane >> 5;
  const float* bg = p.in[14] + (size_t)l * 4096;
  for (int rnd = 0; rnd * (int)gridDim.x < 8 * 128; ++rnd) {
    int ft, tt; if (!tile_at(rnd, 8, 8 * 128, ft, tt)) continue;
    const int f0 = ft * 128;
    f32x16 accM[2][2];
#pragma unroll
    for (int f = 0; f < 2; ++f)
#pragma unroll
      for (int t = 0; t < 2; ++t) accM[f][t] = zero16();
    for (int br = 0; br < 4; ++br) {
      f32x16 acc[2][2];
#pragma unroll
      for (int f = 0; f < 2; ++f)
#pragma unroll
        for (int t = 0; t < 2; ++t) acc[f][t] = zero16();
      gemm_loop<2, 2, 4, 0>(p.Wt + OFF_GATE + (size_t)(br * 1024 + f0) * 1024, 1024, p.hb + (size_t)tt * 256 * 1024, 1024, 1024, acc, lds);
      unsigned gp[2][2][8];
      const int tq = TID(), wfq = tq >> 8, hq = (tq >> 5) & 1;
      const float* bq = bg + br * 1024 + f0 + wfq * 64 + 4 * hq;
#pragma unroll
      for (int f = 0; f < 2; ++f)
#pragma unroll
        for (int j = 0; j < 8; ++j) {
          const float b0 = bq[f * 32 + crow(2 * j, 0)];
          const float b1 = bq[f * 32 + crow(2 * j + 1, 0)];
#pragma unroll
          for (int t = 0; t < 2; ++t) {
            const float g0 = __builtin_amdgcn_rcpf(1.f + __builtin_amdgcn_exp2f(-LOG2E * (acc[f][t][2 * j] + b0)));
            const float g1 = __builtin_amdgcn_rcpf(1.f + __builtin_amdgcn_exp2f(-LOG2E * (acc[f][t][2 * j + 1] + b1)));
            gp[f][t][j] = pk2(g0, g1);
          }
        }
#pragma unroll
      for (int f = 0; f < 2; ++f)
#pragma unroll
        for (int t = 0; t < 2; ++t) acc[f][t] = zero16();
      const int Kb = (br == 0) ? 512 : 256;
      const size_t woff = (br == 0) ? OFF_BRA : OFF_BRB + (size_t)(br - 1) * 1024 * 256;
      const int yoff = (br == 0) ? 0 : 512 + 256 * (br - 1);
      gemm_loop<2, 2, 4, 0>(p.Wt + woff + (size_t)f0 * Kb, Kb, p.Y + (size_t)tt * 256 * NY + yoff, NY, Kb, acc, lds);
#pragma unroll
      for (int f = 0; f < 2; ++f)
#pragma unroll
        for (int t = 0; t < 2; ++t)
#pragma unroll
          for (int j = 0; j < 8; ++j) {
            const unsigned u = gp[f][t][j];
            accM[f][t][2 * j] += __uint_as_float(u << 16) * acc[f][t][2 * j];
            accM[f][t][2 * j + 1] += __uint_as_float(u & 0xffff0000u) * acc[f][t][2 * j + 1];
          }
    }
#pragma unroll
    for (int f = 0; f < 2; ++f)
#pragma unroll
      for (int t = 0; t < 2; ++t) {
        const int token = tt * 256 + (wt * 2 + t) * 32 + r;
#pragma unroll
        for (int g4 = 0; g4 < 4; ++g4) {
          u32x2 w; w[0] = pk2(accM[f][t][4 * g4], accM[f][t][4 * g4 + 1]); w[1] = pk2(accM[f][t][4 * g4 + 2], accM[f][t][4 * g4 + 3]);
          *(u32x2*)(merged + (size_t)token * D + f0 + (wf * 2 + f) * 32 + 8 * g4 + 4 * hh) = w;
        }
      }
  }
}

template <int VAR, int DV>
DI void attn_core(const P& p, int b, int q0, int qoff, int koff, int vf0, int hfox, char* lds, f32x16 (&O)[DV / 32], float& lsum) {
  const int tid = TID(), lane = tid & 63, wave = tid >> 6, r = lane & 31, hh = lane >> 5;
  char* Kt = lds; char* Vt = lds + 64 * ROWB; float* cumt = (float*)(lds + 64 * ROWB + DV * ROWB);
  const int qw = q0 + wave * 32, query = qw + r;
  constexpr float SC2 = 0.125f * LOG2E;
  bf16x8 qf[4];
  {
    const u16* qp = p.PR + (size_t)(b * S + query) * NPR + qoff;
#pragma unroll
    for (int ks = 0; ks < 4; ++ks) qf[ks] = *(const bf16x8*)(qp + ks * 16 + hh * 8);
  }
#pragma unroll
  for (int db = 0; db < DV / 32; ++db) O[db] = zero16();
  float m = -INFINITY, l = 0.f, R = (VAR == 2) ? 1.f : 0.f, cq = 0.f;
  if (VAR == 1) cq = p.CUM[(size_t)(b * 4 + hfox) * S + query];
  const float cq2 = cq * LOG2E;
  const int nkt = q0 / 64 + 4;
  u32x4 rk[1], rv[DV / 64]; float rc = 0.f; u32x2 rm = {0u, 0u};
  auto prefetch = [&](int kt) {
    const int kb = kt * 64;
    {
      const int row = tid >> 3, kc = tid & 7;
      rk[0] = *(const u32x4*)(p.PR + (size_t)(b * S + kb + row) * NPR + koff + kc * 8);
    }
#pragma unroll
    for (int i = 0; i < DV / 64; ++i) {
      const int c = tid + 512 * i, row = c >> 3, kc = c & 7;
      rv[i] = *(const u32x4*)(p.VT + ((size_t)(b * NV + vf0 + row)) * S + kb + kc * 8);
    }
    if (VAR == 1) { if (tid < 64) rc = p.CUM[(size_t)(b * 4 + hfox) * S + kb + tid]; }
    if (VAR == 3) rm = *(const u32x2*)(p.MASK + (size_t)(b * S + query) * 128 + kt * 2);
  };
  prefetch((VAR == 2) ? (nkt - 1) : 0);
  for (int it = 0; it < nkt; ++it) {
    const int kt = (VAR == 2) ? (nkt - 1 - it) : it;
    const int kb = kt * 64;
    __syncthreads();
    {
      const int row = tid >> 3, kc = tid & 7;
      *(u32x4*)(Kt + row * ROWB + kc * 16) = rk[0];
    }
#pragma unroll
    for (int i = 0; i < DV / 64; ++i) {
      const int c = tid + 512 * i, row = c >> 3, kc = c & 7;
      *(u32x4*)(Vt + row * ROWB + kc * 16) = rv[i];
    }
    if (VAR == 1) { if (tid < 64) cumt[tid] = rc * LOG2E; }
    const u32x2 mw = rm;
    __syncthreads();
    if (it + 1 < nkt) prefetch((VAR == 2) ? (kt - 1) : (kt + 1));
#pragma unroll
    for (int ss = 0; ss < 2; ++ss) {
      const int sub = (VAR == 2) ? 1 - ss : ss;
      const int kb2 = kb + sub * 32;
      if (kb2 > qw + 31) continue;
      f32x16 sacc = zero16();
#pragma unroll
      for (int ks = 0; ks < 4; ++ks) {
        bf16x8 a = *(const bf16x8*)(Kt + (sub * 32 + r) * ROWB + ks * 32 + hh * 16);
        sacc = mfma(a, qf[ks], sacc);
      }
      float pv[16];
      if (VAR != 2) {
        const unsigned w = sub ? mw[1] : mw[0];
        const f32x16 sc = sacc;
#pragma unroll
        for (int i = 0; i < 16; ++i) {
          float sv = sc[i];
          if (VAR == 1) sv += cq2 - cumt[sub * 32 + crow(i, hh)];
          pv[i] = sv;
        }
        if (VAR == 3) {
#pragma unroll
          for (int i = 0; i < 16; ++i) pv[i] = (((w >> crow(i, hh)) & 1u) != 0u) ? pv[i] : -INFINITY;
        } else if (kb2 + 31 > qw) {
#pragma unroll
          for (int i = 0; i < 16; ++i) pv[i] = (kb2 + crow(i, hh) <= query) ? pv[i] : -INFINITY;
        }
        float mx = pv[0];
#pragma unroll
        for (int i = 1; i < 16; ++i) mx = fmaxf(mx, pv[i]);
        mx = xmax32(mx);
        const float mn = fmaxf(m, mx);
        const float mu = (mn == -INFINITY) ? 0.f : mn;
        if (__any(mn != m)) {
          const float alpha = __builtin_amdgcn_exp2f(m - mu);
          l *= alpha;
#pragma unroll
          for (int db = 0; db < DV / 32; ++db) O[db] = O[db] * alpha;
          m = mn;
        }
        float ps = 0.f;
#pragma unroll
        for (int i = 0; i < 16; ++i) { pv[i] = __builtin_amdgcn_exp2f(pv[i] - mu); ps += pv[i]; }
        l += xsum32(ps);
      } else {
        float bt[16], om[16];
#pragma unroll
        for (int i = 0; i < 16; ++i) {
          const float zc = fmaxf(sacc[i], -115.f);
          const float e = __builtin_amdgcn_exp2f(-zc);
          const float bb = __builtin_amdgcn_rcpf(1.f + e);
          bt[i] = bb;
          om[i] = e * bb;
        }
        if (kb2 + 31 >= qw) {
#pragma unroll
          for (int i = 0; i < 16; ++i) {
            const bool strict = (kb2 + crow(i, hh)) < query;
            bt[i] = strict ? bt[i] : 0.f;
            om[i] = strict ? om[i] : 1.f;
          }
        }
        float go[4], gx[4];
#pragma unroll
        for (int mm = 0; mm < 4; ++mm) go[mm] = (om[4 * mm] * om[4 * mm + 1]) * (om[4 * mm + 2] * om[4 * mm + 3]);
#pragma unroll
        for (int mm = 0; mm < 4; ++mm) gx[mm] = xoth32(go[mm], hh);
        float tail = 1.f;
#pragma unroll
        for (int mm = 3; mm >= 0; --mm) {
          const float later = tail * (hh == 0 ? gx[mm] : 1.f);
          const float a3 = R * later;
          const float a2 = a3 * om[4 * mm + 3];
          const float a1 = a2 * om[4 * mm + 2];
          const float a0 = a1 * om[4 * mm + 1];
          pv[4 * mm + 3] = bt[4 * mm + 3] * a3;
          pv[4 * mm + 2] = bt[4 * mm + 2] * a2;
          pv[4 * mm + 1] = bt[4 * mm + 1] * a1;
          pv[4 * mm + 0] = bt[4 * mm + 0] * a0;
          tail *= go[mm] * gx[mm];
        }
        R *= tail;
      }
      bf16x8 pf[2];
#pragma unroll
      for (int s2 = 0; s2 < 2; ++s2) {
        u32x4 u;
#pragma unroll
        for (int j = 0; j < 4; ++j) u[j] = pk2(pv[8 * s2 + 2 * j], pv[8 * s2 + 2 * j + 1]);
        pf[s2] = __builtin_bit_cast(bf16x8, u);
      }
#pragma unroll
      for (int db = 0; db < DV / 32; ++db)
#pragma unroll
        for (int s2 = 0; s2 < 2; ++s2) {
          const char* vp = Vt + (db * 32 + r) * ROWB + (sub * 32 + 16 * s2 + 4 * hh) * 2;
          u32x2 lo = *(const u32x2*)vp, hi = *(const u32x2*)(vp + 16);
          u32x4 u; u[0] = lo[0]; u[1] = lo[1]; u[2] = hi[0]; u[3] = hi[1];
          O[db] = mfma(__builtin_bit_cast(bf16x8, u), pf[s2], O[db]);
        }
    }
  }
  lsum = l;
}

template <int DV>
DI void store_y(const P& p, int b, int q0, int ycol, const f32x16 (&O)[DV / 32]) {
  const int lane = TID() & 63, wave = TID() >> 6, r = lane & 31, hh = lane >> 5;
  const int token = b * S + q0 + wave * 32 + r;
#pragma unroll
  for (int db = 0; db < DV / 32; ++db)
#pragma unroll
    for (int g4 = 0; g4 < 4; ++g4) {
      u32x2 w; w[0] = pk2(O[db][4 * g4], O[db][4 * g4 + 1]); w[1] = pk2(O[db][4 * g4 + 2], O[db][4 * g4 + 3]);
      *(u32x2*)(p.Y + (size_t)token * NY + ycol + db * 32 + 8 * g4 + 4 * hh) = w;
    }
}

DI void attn_task_diff(const P& p, int l, int b, int h, int q0, char* lds) {
  const int lane = TID() & 63, hh = lane >> 5;
  const float* lq1 = p.in[8] + l * 64; const float* lk1 = p.in[9] + l * 64;
  const float* lq2 = p.in[10] + l * 64; const float* lk2 = p.in[11] + l * 64;
  float d1 = 0.f, d2 = 0.f;
  for (int i = 0; i < 64; ++i) { d1 += lq1[i] * lk1[i]; d2 += lq2[i] * lk2[i]; }
  const float lam_init = 0.8f - 0.6f * expf(-0.3f * (float)l);
  const float lam = expf(d1) - expf(d2) + lam_init;
  f32x16 O1[4], O2[4]; float l1, l2;
  attn_core<0, 128>(p, b, q0, AQ + h * 128, AK + h * 128, h * 128, 0, lds, O1, l1);
  const float i1 = 1.f / l1;
#pragma unroll
  for (int db = 0; db < 4; ++db)
#pragma unroll
    for (int i = 0; i < 16; ++i) O1[db][i] *= i1;
  attn_core<0, 128>(p, b, q0, AQ + h * 128 + 64, AK + h * 128 + 64, h * 128, 0, lds, O2, l2);
  const float i2 = lam / l2;
  float ss = 0.f;
#pragma unroll
  for (int db = 0; db < 4; ++db)
#pragma unroll
    for (int i = 0; i < 16; ++i) { const float v = O1[db][i] - i2 * O2[db][i]; O1[db][i] = v; ss += v * v; }
  ss = xsum32(ss);
  const float rs = rsqrtf(ss * (1.f / 128.f) + 1e-5f) * (1.f - lam_init);
  const float* dg = p.in[12] + l * 128;
#pragma unroll
  for (int db = 0; db < 4; ++db)
#pragma unroll
    for (int i = 0; i < 16; ++i) O1[db][i] *= rs * dg[db * 32 + crow(i, hh)];
  store_y<128>(p, b, q0, h * 128, O1);
}
template <int VAR>
DI void attn_task_64(const P& p, int b, int h, int q0, char* lds) {
  f32x16 O[2]; float ls;
  constexpr int qo = (VAR == 1) ? BQ : (VAR == 2 ? CQ : DQ);
  constexpr int ko = (VAR == 1) ? BKo : (VAR == 2 ? CK : DK);
  constexpr int vo = (VAR == 1) ? 512 : (VAR == 2 ? 768 : 1024);
  attn_core<VAR, 64>(p, b, q0, qo + h * 64, ko + h * 64, vo + h * 64, h, lds, O, ls);
  if (VAR != 2) {
    const float il = 1.f / ls;
#pragma unroll
    for (int db = 0; db < 2; ++db)
#pragma unroll
      for (int i = 0; i < 16; ++i) O[db][i] *= il;
  }
  store_y<64>(p, b, q0, vo + h * 64, O);
}

DI void idx_task(const P& p, int b, int t0, char* lds) {
  float* sc = (float*)lds;
  const int tid = TID(), lane = tid & 63, wave = tid >> 6, r = lane & 31, hh = lane >> 5;
  __syncthreads();
  bf16x8 afA[4], afB[4];
  {
    const u16* ap = p.PR + (size_t)(b * S + t0 + (r >> 3)) * NPR + IQ + (r & 7) * 64;
#pragma unroll
    for (int ks = 0; ks < 4; ++ks) { afA[ks] = *(const bf16x8*)(ap + ks * 16 + hh * 8); afB[ks] = *(const bf16x8*)(ap + (size_t)4 * NPR + ks * 16 + hh * 8); }
  }
  float iwA[16], iwB[16];
#pragma unroll
  for (int i = 0; i < 16; ++i) {
    iwA[i] = p.IW[(size_t)(b * S + t0 + (i >> 2)) * 8 + (i & 3) + 4 * hh];
    iwB[i] = p.IW[(size_t)(b * S + t0 + 4 + (i >> 2)) * 8 + (i & 3) + 4 * hh];
  }
  const int ntile = (t0 + 7) / 32 + 1;
  for (int tb = wave * 4; tb < ntile; tb += 32) {
    bf16x8 bb[4][4];
#pragma unroll
    for (int u = 0; u < 4; ++u) {
      const int tile = min(tb + u, ntile - 1);
      const u16* bp = p.PR + (size_t)(b * S + tile * 32 + r) * NPR + IK;
#pragma unroll
      for (int ks = 0; ks < 4; ++ks) bb[u][ks] = *(const bf16x8*)(bp + ks * 16 + hh * 8);
    }
#pragma unroll
    for (int u = 0; u < 4; ++u) {
      const int tile = tb + u;
      f32x16 accA = zero16(), accB = zero16();
#pragma unroll
      for (int ks = 0; ks < 4; ++ks) { accA = mfma(afA[ks], bb[u][ks], accA); accB = mfma(afB[ks], bb[u][ks], accB); }
      float sA[4], sB[4];
#pragma unroll
      for (int q = 0; q < 4; ++q) {
        float va = 0.f, vb = 0.f;
#pragma unroll
        for (int j = 0; j < 4; ++j) { va += fmaxf(accA[4 * q + j], 0.f) * iwA[4 * q + j]; vb += fmaxf(accB[4 * q + j], 0.f) * iwB[4 * q + j]; }
        sA[q] = xsum32(va); sB[q] = xsum32(vb);
      }
      if (tile < ntile) {
        sc[(2 * hh) * 4096 + tile * 32 + r] = hh ? sA[2] : sA[0];
        sc[(2 * hh + 1) * 4096 + tile * 32 + r] = hh ? sA[3] : sA[1];
        sc[(4 + 2 * hh) * 4096 + tile * 32 + r] = hh ? sB[2] : sB[0];
        sc[(5 + 2 * hh) * 4096 + tile * 32 + r] = hh ? sB[3] : sB[1];
      }
    }
  }
  __syncthreads();
  const int t = __builtin_amdgcn_readfirstlane(t0 + wave);
  unsigned key[64];
#pragma unroll
  for (int c = 0; c < 64; ++c) {
    const int s = c * 64 + lane;
    unsigned u = __float_as_uint(sc[wave * 4096 + s]);
    u = (u & 0x80000000u) ? ~u : (u | 0x80000000u);
    key[c] = (s <= t) ? u : 0u;
  }
  u64 mymask = 0;
  const int nch = (t >> 6) + 1;
  if (t >= 256) {
    unsigned T = 0;
    bool exact = false;
    for (int bit = 31; bit >= 0; --bit) {
      const unsigned cand = T | (1u << bit);
      int cl = 0;
#pragma unroll
      for (int g = 0; g < 8; ++g) {
        if (g * 8 < nch) {
#pragma unroll
          for (int c = g * 8; c < g * 8 + 8; ++c) cl += (key[c] >= cand) ? 1 : 0;
        }
      }
      int cnt = 0;
#pragma unroll
      for (int k2 = 0; k2 < 7; ++k2) cnt += __popcll(__ballot(((cl >> k2) & 1) != 0)) << k2;
      if (cnt >= 256) T = cand;
      if (cnt == 256) { exact = true; break; }
    }
    if (exact) {
#pragma unroll
      for (int c = 0; c < 64; ++c) {
        const u64 mk = __ballot(key[c] >= T);
        if (lane == c) mymask = mk;
      }
    } else {
    int ngt = 0;
#pragma unroll
    for (int c = 0; c < 64; ++c) ngt += __popcll(__ballot(key[c] > T));
    int rem = 256 - ngt;
#pragma unroll
    for (int c = 0; c < 64; ++c) {
      const u64 gt = __ballot(key[c] > T);
      u64 eq = __ballot(key[c] == T);
      int e = __popcll(eq);
      while (e > rem) { eq &= ~(1ull << (63 - __clzll(eq))); --e; }
      rem -= e;
      const u64 mk = gt | eq;
      if (lane == c) mymask = mk;
    }
    }
  } else {
#pragma unroll
    for (int c = 0; c < 64; ++c) {
      const u64 mk = __ballot(c * 64 + lane <= t);
      if (lane == c) mymask = mk;
    }
  }
  *(u64*)(p.MASK + (size_t)(b * S + t) * 128 + lane * 2) = mymask;
}

DI void scan_task(const P& p, int pair) {
  const int lane = TID() & 63;
  const int b = pair >> 2, h = pair & 3;
  const float* src = p.FL + ((size_t)(b * S + lane * 64)) * 4 + h;
  float v[64];
#pragma unroll
  for (int j = 0; j < 64; ++j) v[j] = src[j * 4];
#pragma unroll
  for (int j = 1; j < 64; ++j) v[j] += v[j - 1];
  float tot = v[63], inc = tot;
#pragma unroll
  for (int o = 1; o < 64; o <<= 1) { const float u = __shfl_up(inc, o); if (lane >= o) inc += u; }
  const float off = inc - tot;
  float* dst = p.CUM + (size_t)pair * S + lane * 64;
#pragma unroll
  for (int j = 0; j < 64; j += 4) {
    f32x4 o4; o4[0] = v[j] + off; o4[1] = v[j + 1] + off; o4[2] = v[j + 2] + off; o4[3] = v[j + 3] + off;
    *(f32x4*)(dst + j) = o4;
  }
}

DI int zz_id(int r) { const int G = gridDim.x, bb = blockIdx.x; return r * G + ((r & 1) ? (G - 1 - bb) : bb); }
DI bool attn_map(int r, int& bh, int& qt) {
  if (gridDim.x == 256) {
    if (r >= 2) return false;
    const int x = blockIdx.x & 7, jb = blockIdx.x >> 3;
    bh = 4 * x + (jb >> 3);
    qt = (r == 0) ? 15 - (jb & 7) : (jb & 7);
    return true;
  }
  if (r * (int)gridDim.x >= 512) return false;
  const int id = zz_id(r);
  if (id >= 512) { bh = -1; return true; }
  bh = id & 31; qt = 15 - (id >> 5);
  return true;
}
DI void phase_mix1(const P& p, int l, char* lds) {
  for (int task = blockIdx.x; task < 4; task += gridDim.x) scan_task(p, task * 8 + (TID() >> 6));
  for (int r = 0; r * (int)gridDim.x < 4096; ++r) {
    const int id = zz_id(r); if (id >= 4096) continue;
    const int trev = id >> 3, b = id & 7;
    idx_task(p, b, (511 - trev) * 8, lds);
  }
  int bh, qt;
  for (int r = 0; attn_map(r, bh, qt); ++r) { if (bh >= 0) attn_task_diff(p, l, bh >> 2, bh & 3, qt * 256, lds); }
  for (int r = 0; attn_map(r, bh, qt); ++r) { if (bh >= 0) attn_task_64<2>(p, bh >> 2, bh & 3, qt * 256, lds); }
}
DI void phase_mix2(const P& p, char* lds) {
  int bh, qt;
  for (int r = 0; attn_map(r, bh, qt); ++r) { if (bh >= 0) attn_task_64<1>(p, bh >> 2, bh & 3, qt * 256, lds); }
  for (int r = 0; attn_map(r, bh, qt); ++r) { if (bh >= 0) attn_task_64<3>(p, bh >> 2, bh & 3, qt * 256, lds); }
}

__global__ void __launch_bounds__(512, 2) mega_kernel(P p) {
  __shared__ __attribute__((aligned(16))) char lds[LDS_BYTES];
  cg::grid_group grid = cg::this_grid();
  u16* act = p.PR; u16* merged = p.PR;
  for (int l = 0; l < 2; ++l) {
    const float* xcur = (l == 0) ? p.in[0] : p.xres;
    phase_conv(p, l, lds); phase_norm(xcur, p.in[2] + l * D, p.hb); grid.sync();
    phase_gu(p, p.Wt + OFF_GU1, act, lds); grid.sync();
    phase_resid(p.Wt + OFF_DN1, act, DFF, xcur, p.xres, 0.5f, lds); grid.sync();
    phase_norm(p.xres, p.in[5] + l * D, p.hb); grid.sync();
    phase_proj(p, l, lds); grid.sync();
    phase_mix1(p, l, lds); grid.sync();
    phase_mix2(p, lds); grid.sync();
    phase_merge(p, l, merged, lds); grid.sync();
    phase_resid(p.Wt + OFF_OUT, merged, D, p.xres, p.xres, 1.0f, lds); grid.sync();
    phase_norm(p.xres, p.in[20] + l * D, p.hb); grid.sync();
    phase_gu(p, p.Wt + OFF_GU2, act, lds); grid.sync();
    phase_resid(p.Wt + OFF_DN2, act, DFF, p.xres, p.xres, 0.5f, lds); grid.sync();
  }
  phase_final_norm(p.xres, p.in[23]);
}

extern "C" void kernel_launch(void* const* d_in, const int* in_sizes, int n_in, void* d_out, int out_size, void* d_ws, size_t ws_size, hipStream_t stream) {
  P p{};
  for (int i = 0; i < 24; ++i) p.in[i] = (const float*)d_in[i];
  p.pos = (const int*)d_in[1];
  p.xres = (float*)d_out;
  char* w = (char*)d_ws; size_t off = 0;
  auto take = [&](size_t bytes) { char* r = w + off; off += (bytes + 255) & ~(size_t)255; return r; };
  p.Wt = (u16*)take(WT_ELEMS * 2);
  p.hb = (u16*)take((size_t)M * D * 2);
  p.PR = (u16*)take((size_t)M * NPR * 2);
  p.VT = (u16*)take((size_t)NB * NV * S * 2);
  p.Y = (u16*)take((size_t)M * NY * 2);
  p.MASK = (unsigned*)take((size_t)M * 128 * 4);
  p.FL = (float*)take((size_t)M * 4 * 4);
  p.IW = (float*)take((size_t)M * 8 * 4);
  p.CUM = (float*)take((size_t)M * 4 * 4);
  p.COS = (float*)take((size_t)S * 8 * 4);
  p.SIN = (float*)take((size_t)S * 8 * 4);
  if (off > ws_size) { fprintf(stderr, "workspace too small: need %zu have %zu\n", off, ws_size); return; }
  static int grid_blocks = 0;
  if (!grid_blocks) {
    int dev = 0, cus = 0, per_cu = 0;
    hipGetDevice(&dev);
    hipDeviceGetAttribute(&cus, hipDeviceAttributeMultiprocessorCount, dev);
    hipOccupancyMaxActiveBlocksPerMultiprocessor(&per_cu, mega_kernel, 512, 0);
    grid_blocks = cus * (per_cu < 1 ? 1 : per_cu);
  }
  void* args[] = {&p};
  hipError_t e = hipLaunchCooperativeKernel((void*)mega_kernel, dim3(grid_blocks), dim3(512), args, 0, stream);
  if (e != hipSuccess) fprintf(stderr, "cooperative launch failed: %s (grid %d)\n", hipGetErrorString(e), grid_blocks);
}
```

```cpp
#include <hip/hip_runtime.h>
#include <hip/hip_cooperative_groups.h>
#include <cstdio>
namespace cg = cooperative_groups;

#define DI __device__ __forceinline__
typedef unsigned short u16;
typedef unsigned long long u64;
typedef __attribute__((ext_vector_type(8))) short bf16x8;
typedef __attribute__((ext_vector_type(16))) float f32x16;
typedef __attribute__((ext_vector_type(4))) float f32x4;
typedef __attribute__((ext_vector_type(2))) float f32x2;
typedef __attribute__((ext_vector_type(2))) __bf16 bf2;
typedef __attribute__((ext_vector_type(4))) unsigned u32x4;
typedef __attribute__((ext_vector_type(2))) unsigned u32x2;

constexpr int D = 1024, NB = 8, S = 4096, M = NB * S, DFF = 2816;
constexpr int NPR = 3200, NV = 1280, NY = 1280;
constexpr int AQ = 0, AK = 512, BQ = 1024, BKo = 1280, CQ = 1536, CK = 1792, DQ = 2048, DK = 2304, IQ = 2560, IK = 3072, SMALL = 3136;
constexpr size_t OFF_GU1 = 0;
constexpr size_t OFF_DN1 = OFF_GU1 + (size_t)5632 * 1024;
constexpr size_t OFF_IN = OFF_DN1 + (size_t)1024 * 2816;
constexpr size_t OFF_GATE = OFF_IN + (size_t)4608 * 1024;
constexpr size_t OFF_BRA = OFF_GATE + (size_t)4096 * 1024;
constexpr size_t OFF_BRB = OFF_BRA + (size_t)1024 * 512;
constexpr size_t OFF_BRC = OFF_BRB + (size_t)1024 * 256;
constexpr size_t OFF_BRD = OFF_BRC + (size_t)1024 * 256;
constexpr size_t OFF_OUT = OFF_BRD + (size_t)1024 * 256;
constexpr size_t OFF_GU2 = OFF_OUT + (size_t)1024 * 1024;
constexpr size_t OFF_DN2 = OFF_GU2 + (size_t)5632 * 1024;
constexpr size_t WT_ELEMS = OFF_DN2 + (size_t)1024 * 2816;

constexpr float LOG2E = 1.4426950408889634f;
constexpr int LDS_BYTES = 131072;
constexpr int ROWB = 144;

struct P {
  const float* in[24];
  const int* pos;
  float* xres;
  u16* Wt; u16* hb; u16* PR; u16* VT; u16* Y;
  unsigned* MASK; float* FL; float* IW; float* CUM; float* COS; float* SIN;
};

DI int TID() { int t = (int)__builtin_amdgcn_workitem_id_x(); asm volatile("" : "+v"(t)); return t; }
DI unsigned pk2(float a, float b) { f32x2 v = {a, b}; bf2 r = __builtin_convertvector(v, bf2); return __builtin_bit_cast(unsigned, r); }
DI u16 f2bf(float a) { __bf16 h = (__bf16)a; return __builtin_bit_cast(u16, h); }
DI float wsum(float v) {
#pragma unroll
  for (int o = 32; o > 0; o >>= 1) v += __shfl_xor(v, o);
  return v;
}
DI float xmax32(float x) { auto r2 = __builtin_amdgcn_permlane32_swap(__float_as_uint(x), __float_as_uint(x), false, false); return fmaxf(__uint_as_float(r2[0]), __uint_as_float(r2[1])); }
DI float xsum32(float x) { auto r2 = __builtin_amdgcn_permlane32_swap(__float_as_uint(x), __float_as_uint(x), false, false); return __uint_as_float(r2[0]) + __uint_as_float(r2[1]); }
DI float xoth32(float x, int hh) { auto r2 = __builtin_amdgcn_permlane32_swap(__float_as_uint(x), __float_as_uint(x), false, false); return __uint_as_float(hh ? r2[0] : r2[1]); }
DI int wave_sum_i32(int v) {
  v += __builtin_amdgcn_update_dpp(0, v, 0xB1, 0xf, 0xf, false);
  v += __builtin_amdgcn_update_dpp(0, v, 0x4E, 0xf, 0xf, false);
  v += __builtin_amdgcn_update_dpp(0, v, 0x141, 0xf, 0xf, false);
  v += __builtin_amdgcn_update_dpp(0, v, 0x140, 0xf, 0xf, false);
  v += __builtin_amdgcn_update_dpp(0, v, 0x142, 0xa, 0xf, false);
  v += __builtin_amdgcn_update_dpp(0, v, 0x143, 0xc, 0xf, false);
  return __builtin_amdgcn_readlane(v, 63);
}
DI constexpr int crow(int i, int hh) { return (i & 3) + 8 * (i >> 2) + 4 * hh; }
DI f32x16 mfma(bf16x8 a, bf16x8 b, f32x16 c) { return __builtin_amdgcn_mfma_f32_32x32x16_bf16(a, b, c, 0, 0, 0); }
DI f32x16 zero16() { f32x16 z;
#pragma unroll
  for (int i = 0; i < 16; ++i) z[i] = 0.f; return z; }

DI void phase_norm(const float* __restrict__ src, const float* __restrict__ g, u16* __restrict__ dst) {
  const int lane = TID() & 63;
  const int wave = (blockIdx.x * 512 + TID()) >> 6, nw = gridDim.x * 8;
  for (int row = wave; row < M; row += nw) {
    const f32x4* p = (const f32x4*)(src + (size_t)row * D);
    f32x4 v[4]; float ss = 0.f;
#pragma unroll
    for (int j = 0; j < 4; ++j) { v[j] = p[lane + 64 * j]; ss += v[j][0] * v[j][0] + v[j][1] * v[j][1] + v[j][2] * v[j][2] + v[j][3] * v[j][3]; }
    ss = wsum(ss);
    const float rs = rsqrtf(ss * (1.f / D) + 1e-6f);
#pragma unroll
    for (int j = 0; j < 4; ++j) {
      f32x4 gg = ((const f32x4*)g)[lane + 64 * j];
      u32x2 o; o[0] = pk2(v[j][0] * rs * gg[0], v[j][1] * rs * gg[1]); o[1] = pk2(v[j][2] * rs * gg[2], v[j][3] * rs * gg[3]);
      *(u32x2*)(dst + (size_t)row * D + (lane + 64 * j) * 4) = o;
    }
  }
}
DI void phase_final_norm(float* __restrict__ x, const float* __restrict__ g) {
  const int lane = TID() & 63;
  const int wave = (blockIdx.x * 512 + TID()) >> 6, nw = gridDim.x * 8;
  for (int row = wave; row < M; row += nw) {
    f32x4* p = (f32x4*)(x + (size_t)row * D);
    f32x4 v[4]; float ss = 0.f;
#pragma unroll
    for (int j = 0; j < 4; ++j) { v[j] = p[lane + 64 * j]; ss += v[j][0] * v[j][0] + v[j][1] * v[j][1] + v[j][2] * v[j][2] + v[j][3] * v[j][3]; }
    ss = wsum(ss);
    const float rs = rsqrtf(ss * (1.f / D) + 1e-6f);
#pragma unroll
    for (int j = 0; j < 4; ++j) {
      f32x4 gg = ((const f32x4*)g)[lane + 64 * j];
      f32x4 o; o[0] = v[j][0] * rs * gg[0]; o[1] = v[j][1] * rs * gg[1]; o[2] = v[j][2] * rs * gg[2]; o[3] = v[j][3] * rs * gg[3];
      p[lane + 64 * j] = o;
    }
  }
}

DI int map_gu(int n) { int c = (n < DFF) ? n : n - DFF; return (c >> 5) * 64 + (c & 31) + ((n < DFF) ? 0 : 32); }
DI int map_in(int n) {
  if (n < 512) return n;
  if (n < 1024) return n;
  if (n < 1536) return n - 1024 + 3200;
  if (n < 1792) return n - 1536 + BQ;
  if (n < 2048) return n - 1792 + BKo;
  if (n < 2304) return n - 2048 + 3200 + 512;
  if (n < 2308) return n - 2304 + SMALL;
  if (n < 2564) return n - 2308 + CQ;
  if (n < 2820) return n - 2564 + CK;
  if (n < 3076) return n - 2820 + 3200 + 768;
  if (n < 3332) return n - 3076 + DQ;
  if (n < 3588) return n - 3332 + DK;
  if (n < 3844) return n - 3588 + 3200 + 1024;
  if (n < 4356) return n - 3844 + IQ;
  if (n < 4420) return n - 4356 + IK;
  return n - 4420 + SMALL + 4;
}
DI void conv_w(const float* __restrict__ W, int K, int N, u16* __restrict__ Wt, int mp, char* lds) {
  const int tid = TID(), half = tid >> 8, t8 = tid & 255, tn = t8 & 15, tk = t8 >> 4;
  char* my = lds + half * (64 * ROWB);
  const int ntn = (N + 63) >> 6, ntk = K >> 6, ntile = ntn * ntk;
  for (int base = 2 * blockIdx.x; base < ntile; base += 2 * gridDim.x) {
    const int tile = base + half;
    const bool on = tile < ntile;
    const int n0 = (tile % ntn) * 64, k0 = (tile / ntn) * 64;
    f32x4 v[4];
    const int n = n0 + 4 * tn;
#pragma unroll
    for (int i = 0; i < 4; ++i) {
      if (on && n < N) v[i] = *(const f32x4*)(W + (size_t)(k0 + 4 * tk + i) * N + n);
      else { v[i][0] = 0.f; v[i][1] = 0.f; v[i][2] = 0.f; v[i][3] = 0.f; }
    }
    __syncthreads();
#pragma unroll
    for (int j = 0; j < 4; ++j) {
      u32x2 w; w[0] = pk2(v[0][j], v[1][j]); w[1] = pk2(v[2][j], v[3][j]);
      *(u32x2*)(my + (4 * tn + j) * ROWB + tk * 8) = w;
    }
    __syncthreads();
#pragma unroll
    for (int ps = 0; ps < 2; ++ps) {
      const int nn = (t8 >> 3) + 32 * ps, c = t8 & 7, ng = n0 + nn;
      if (on && ng < N) {
        const int np = (mp == 0) ? ng : (mp == 1 ? map_gu(ng) : map_in(ng));
        *(u32x4*)(Wt + (size_t)np * K + k0 + 8 * c) = *(const u32x4*)(my + nn * ROWB + c * 16);
      }
    }
  }
}
DI void phase_conv(const P& p, int l, char* lds) {
  conv_w(p.in[3] + (size_t)l * 1024 * 5632, 1024, 5632, p.Wt + OFF_GU1, 1, lds);
  conv_w(p.in[4] + (size_t)l * 2816 * 1024, 2816, 1024, p.Wt + OFF_DN1, 0, lds);
  conv_w(p.in[6] + (size_t)l * 1024 * 4428, 1024, 4428, p.Wt + OFF_IN, 2, lds);
  conv_w(p.in[13] + (size_t)l * 1024 * 4096, 1024, 4096, p.Wt + OFF_GATE, 0, lds);
  conv_w(p.in[15] + (size_t)l * 512 * 1024, 512, 1024, p.Wt + OFF_BRA, 0, lds);
  conv_w(p.in[16] + (size_t)l * 256 * 1024, 256, 1024, p.Wt + OFF_BRB, 0, lds);
  conv_w(p.in[17] + (size_t)l * 256 * 1024, 256, 1024, p.Wt + OFF_BRC, 0, lds);
  conv_w(p.in[18] + (size_t)l * 256 * 1024, 256, 1024, p.Wt + OFF_BRD, 0, lds);
  conv_w(p.in[19] + (size_t)l * 1024 * 1024, 1024, 1024, p.Wt + OFF_OUT, 0, lds);
  conv_w(p.in[21] + (size_t)l * 1024 * 5632, 1024, 5632, p.Wt + OFF_GU2, 1, lds);
  conv_w(p.in[22] + (size_t)l * 2816 * 1024, 2816, 1024, p.Wt + OFF_DN2, 0, lds);
  const int gt = blockIdx.x * 512 + TID(), nt = gridDim.x * 512;
  for (int i = gt; i < 52 * 1024; i += nt) p.Wt[OFF_IN + (size_t)3148 * 1024 + i] = 0;
  for (int i = gt; i < 128 * 1024; i += nt) p.Wt[OFF_IN + (size_t)4480 * 1024 + i] = 0;
  if (l == 0) {
    for (int i = gt; i < S * 8; i += nt) {
      const int s = i >> 3, c = i & 7;
      const float freq = powf(500000.0f, -(float)(2 * c) / 16.0f);
      const float ang = (float)p.pos[s] * freq;
      p.COS[i] = cosf(ang); p.SIN[i] = sinf(ang);
    }
  }
}

#define LAS __attribute__((address_space(3)))
template <int WF, int WT, int WGT, int PF = 1>
DI void gemm_loop(const u16* __restrict__ A, size_t lda, const u16* __restrict__ B, size_t ldb, int K, f32x16 (&acc)[WF][WT], char* lds) {
  constexpr int WGF = 8 / WGT;
  constexpr int BF = 32 * WF * WGF, BT = 32 * WT * WGT;
  constexpr int ABYTES = BF * 128, BBYTES = BT * 128, STAGE = ABYTES + BBYTES;
  constexpr int IA = BF / 64, IB = BT / 64;
  static_assert(2 * STAGE <= LDS_BYTES, "lds");
  const int tid = TID(), lane = tid & 63, wave = tid >> 6;
  const int wf = wave / WGT, wt = wave % WGT, r = lane & 31, hh = lane >> 5;
  const int kcs = (tid & 7) ^ ((tid >> 4) & 7);
  const u16* ga = A + (size_t)(tid >> 3) * lda + kcs * 8;
  const u16* gb = B + (size_t)(tid >> 3) * ldb + kcs * 8;
  LAS char* l3 = (LAS char*)lds;
  const int sw = (r >> 1) & 7;
  __syncthreads();
#pragma unroll
  for (int i = 0; i < IA; ++i) __builtin_amdgcn_global_load_lds((const unsigned*)(ga + (size_t)i * 64 * lda), (LAS unsigned*)(l3 + i * 8192 + wave * 1024), 16, 0, 0);
#pragma unroll
  for (int i = 0; i < IB; ++i) __builtin_amdgcn_global_load_lds((const unsigned*)(gb + (size_t)i * 64 * ldb), (LAS unsigned*)(l3 + ABYTES + i * 8192 + wave * 1024), 16, 0, 0);
  const int nk = K >> 6;
  for (int kt = 0; kt < nk; ++kt) {
    __syncthreads();
    if (kt + 1 < nk) {
      const int nb = ((kt + 1) & 1) * STAGE, k0 = (kt + 1) * 64;
#pragma unroll
      for (int i = 0; i < IA; ++i) __builtin_amdgcn_global_load_lds((const unsigned*)(ga + (size_t)i * 64 * lda + k0), (LAS unsigned*)(l3 + nb + i * 8192 + wave * 1024), 16, 0, 0);
#pragma unroll
      for (int i = 0; i < IB; ++i) __builtin_amdgcn_global_load_lds((const unsigned*)(gb + (size_t)i * 64 * ldb + k0), (LAS unsigned*)(l3 + nb + ABYTES + i * 8192 + wave * 1024), 16, 0, 0);
    }
    const char* sa = lds + (kt & 1) * STAGE;
    const char* sb = sa + ABYTES;
    bf16x8 af[PF + 1][WF], bfr[PF + 1][WT];
    if (PF) {
      const int co = ((0 * 2 + hh) ^ sw) << 4;
#pragma unroll
      for (int f = 0; f < WF; ++f) af[0][f] = *(const bf16x8*)(sa + ((wf * WF + f) * 32 + r) * 128 + co);
#pragma unroll
      for (int t = 0; t < WT; ++t) bfr[0][t] = *(const bf16x8*)(sb + ((wt * WT + t) * 32 + r) * 128 + co);
    }
#pragma unroll
    for (int ks = 0; ks < 4; ++ks) {
      const int ld = PF ? ks + 1 : ks, li = PF ? ((ks + 1) & 1) : 0, ci = PF ? (ks & 1) : 0;
      if (ld < 4) {
        const int co = ((ld * 2 + hh) ^ sw) << 4;
#pragma unroll
        for (int f = 0; f < WF; ++f) af[li][f] = *(const bf16x8*)(sa + ((wf * WF + f) * 32 + r) * 128 + co);
#pragma unroll
        for (int t = 0; t < WT; ++t) bfr[li][t] = *(const bf16x8*)(sb + ((wt * WT + t) * 32 + r) * 128 + co);
      }
#pragma unroll
      for (int f = 0; f < WF; ++f)
#pragma unroll
        for (int t = 0; t < WT; ++t) acc[f][t] = mfma(af[ci][f], bfr[ci][t], acc[f][t]);
    }
    __syncthreads();
  }
}
DI bool tile_at(int round, int NF, int ntiles, int& ft, int& tt) {
  const int G8 = gridDim.x >> 3;
  const int L = (round * 8 + (int)(blockIdx.x & 7)) * G8 + (int)(blockIdx.x >> 3);
  if (L >= ntiles) return false;
  const int tg = L / (NF * 8), rem = L - tg * NF * 8;
  ft = rem >> 3; tt = tg * 8 + (rem & 7);
  return true;
}

DI void phase_gu(const P& p, const u16* __restrict__ Wt, u16* __restrict__ act, char* lds) {
  const int lane = TID() & 63, wave = TID() >> 6, wf = wave >> 2, wt = wave & 3, r = lane & 31, hh = lane >> 5;
  for (int rnd = 0; rnd * (int)gridDim.x < 22 * 128; ++rnd) {
    int ft, tt; if (!tile_at(rnd, 22, 22 * 128, ft, tt)) continue;
    f32x16 acc[4][2];
#pragma unroll
    for (int f = 0; f < 4; ++f)
#pragma unroll
      for (int t = 0; t < 2; ++t) acc[f][t] = zero16();
    gemm_loop<4, 2, 4>(Wt + (size_t)ft * 256 * 1024, 1024, p.hb + (size_t)tt * 256 * 1024, 1024, 1024, acc, lds);
#pragma unroll
    for (int t = 0; t < 2; ++t) {
      const int token = tt * 256 + (wt * 2 + t) * 32 + r;
#pragma unroll
      for (int pr = 0; pr < 2; ++pr) {
        const int c0 = ft * 128 + wf * 64 + pr * 32;
#pragma unroll
        for (int g4 = 0; g4 < 4; ++g4) {
          float o[4];
#pragma unroll
          for (int j = 0; j < 4; ++j) { const float g = acc[2 * pr][t][4 * g4 + j], u = acc[2 * pr + 1][t][4 * g4 + j]; o[j] = g * __builtin_amdgcn_rcpf(1.f + __builtin_amdgcn_exp2f(-LOG2E * g)) * u; }
          u32x2 w; w[0] = pk2(o[0], o[1]); w[1] = pk2(o[2], o[3]);
          *(u32x2*)(act + (size_t)token * DFF + c0 + 8 * g4 + 4 * hh) = w;
        }
      }
    }
  }
}
DI void phase_resid(const u16* __restrict__ Wt, const u16* __restrict__ B, int K, const float* __restrict__ xsrc, float* __restrict__ xout, float alpha, char* lds) {
  const int lane = TID() & 63, wave = TID() >> 6, wf = wave >> 2, wt = wave & 3, r = lane & 31, hh = lane >> 5;
  for (int rnd = 0; rnd * (int)gridDim.x < 4 * 128; ++rnd) {
    int ft, tt; if (!tile_at(rnd, 4, 4 * 128, ft, tt)) continue;
    f32x16 acc[4][2];
#pragma unroll
    for (int f = 0; f < 4; ++f)
#pragma unroll
      for (int t = 0; t < 2; ++t) acc[f][t] = zero16();
    gemm_loop<4, 2, 4>(Wt + (size_t)ft * 256 * K, K, B + (size_t)tt * 256 * K, K, K, acc, lds);
#pragma unroll
    for (int f = 0; f < 4; ++f)
#pragma unroll
      for (int t = 0; t < 2; ++t) {
        const int token = tt * 256 + (wt * 2 + t) * 32 + r;
        const int fb = ft * 256 + (wf * 4 + f) * 32;
#pragma unroll
        for (int g4 = 0; g4 < 4; ++g4) {
          const size_t off = (size_t)token * D + fb + 8 * g4 + 4 * hh;
          f32x4 xv = *(const f32x4*)(xsrc + off);
#pragma unroll
          for (int j = 0; j < 4; ++j) xv[j] += alpha * acc[f][t][4 * g4 + j];
          *(f32x4*)(xout + off) = xv;
        }
      }
  }
}
DI void phase_proj(const P& p, int l, char* lds) {
  const int lane = TID() & 63, wave = TID() >> 6, wf = wave >> 2, wt = wave & 3, r = lane & 31, hh = lane >> 5;
  const float* bf = p.in[7] + l * 4;
  for (int rnd = 0; rnd * (int)gridDim.x < 18 * 128; ++rnd) {
    int ft, tt; if (!tile_at(rnd, 18, 18 * 128, ft, tt)) continue;
    f32x16 acc[4][2];
#pragma unroll
    for (int f = 0; f < 4; ++f)
#pragma unroll
      for (int t = 0; t < 2; ++t) acc[f][t] = zero16();
    gemm_loop<4, 2, 4>(p.Wt + OFF_IN + (size_t)ft * 256 * 1024, 1024, p.hb + (size_t)tt * 256 * 1024, 1024, 1024, acc, lds);
#pragma unroll
    for (int f = 0; f < 4; ++f)
#pragma unroll
      for (int t = 0; t < 2; ++t) {
        const int token = tt * 256 + (wt * 2 + t) * 32 + r;
        const int fb = ft * 256 + (wf * 4 + f) * 32;
        const int sidx = token & (S - 1), b = token >> 12;
        if (fb < 3200) {
          const bool rope = ((fb & 63) == 0) && (fb < 1024 || (fb >= 2048 && fb < SMALL));
          if (rope) {
            const f32x4 cs = *(const f32x4*)(p.COS + sidx * 8 + 4 * hh);
            const f32x4 sn = *(const f32x4*)(p.SIN + sidx * 8 + 4 * hh);
#pragma unroll
            for (int j = 0; j < 4; ++j) {
              const float x1 = acc[f][t][j], x2 = acc[f][t][4 + j];
              acc[f][t][j] = x1 * cs[j] - x2 * sn[j];
              acc[f][t][4 + j] = x2 * cs[j] + x1 * sn[j];
            }
          }
          const bool isq = (fb < 512) || (fb >= BQ && fb < BKo) || (fb >= CQ && fb < CK) || (fb >= DQ && fb < DK);
          if (isq) acc[f][t] = acc[f][t] * (0.125f * LOG2E);
          if (fb == SMALL) {
            if (hh == 0) {
#pragma unroll
              for (int j = 0; j < 4; ++j) {
                const float z = acc[f][t][j] + bf[j];
                p.FL[(size_t)token * 4 + j] = fminf(z, 0.f) - __logf(1.f + __expf(-fabsf(z)));
                p.IW[(size_t)token * 8 + 4 + j] = acc[f][t][4 + j];
              }
            } else {
#pragma unroll
              for (int j = 0; j < 4; ++j) p.IW[(size_t)token * 8 + j] = acc[f][t][j];
            }
          }
#pragma unroll
          for (int g4 = 0; g4 < 4; ++g4) {
            u32x2 w; w[0] = pk2(acc[f][t][4 * g4], acc[f][t][4 * g4 + 1]); w[1] = pk2(acc[f][t][4 * g4 + 2], acc[f][t][4 * g4 + 3]);
            *(u32x2*)(p.PR + (size_t)token * NPR + fb + 8 * g4 + 4 * hh) = w;
          }
        } else if (fb < 4480) {
          const int vf0 = fb - 3200;
#pragma unroll
          for (int i = 0; i < 16; ++i) p.VT[((size_t)(b * NV + vf0 + crow(i, hh))) * S + sidx] = f2bf(acc[f][t][i]);
        }
      }
  }
}
DI void phase_merge(const P& p, int l, u16* __restrict__ merged, char* lds) {
  const int lane = TID() & 63, wave = TID() >> 6, wf = wave >> 2, wt = wave & 3, r = lane & 31, hh = lane >> 5;
  const float* bg = p.in[14] + (size_t)l * 4096;
  for (int rnd = 0; rnd * (int)gridDim.x < 8 * 128; ++rnd) {
    int ft, tt; if (!tile_at(rnd, 8, 8 * 128, ft, tt)) continue;
    const int f0 = ft * 128;
    f32x16 accM[2][2];
#pragma unroll
    for (int f = 0; f < 2; ++f)
#pragma unroll
      for (int t = 0; t < 2; ++t) accM[f][t] = zero16();
    for (int br = 0; br < 4; ++br) {
      f32x16 acc[2][2];
#pragma unroll
      for (int f = 0; f < 2; ++f)
#pragma unroll
        for (int t = 0; t < 2; ++t) acc[f][t] = zero16();
      gemm_loop<2, 2, 4, 0>(p.Wt + OFF_GATE + (size_t)(br * 1024 + f0) * 1024, 1024, p.hb + (size_t)tt * 256 * 1024, 1024, 1024, acc, lds);
      unsigned gp[2][2][8];
      const int tq = TID(), wfq = tq >> 8, hq = (tq >> 5) & 1;
      const float* bq = bg + br * 1024 + f0 + wfq * 64 + 4 * hq;
#pragma unroll
      for (int f = 0; f < 2; ++f)
#pragma unroll
        for (int j = 0; j < 8; ++j) {
          const float b0 = bq[f * 32 + crow(2 * j, 0)];
          const float b1 = bq[f * 32 + crow(2 * j + 1, 0)];
#pragma unroll
          for (int t = 0; t < 2; ++t) {
            const float g0 = __builtin_amdgcn_rcpf(1.f + __builtin_amdgcn_exp2f(-LOG2E * (acc[f][t][2 * j] + b0)));
            const float g1 = __builtin_amdgcn_rcpf(1.f + __builtin_amdgcn_exp2f(-LOG2E * (acc[f][t][2 * j + 1] + b1)));
            gp[f][t][j] = pk2(g0, g1);
          }
        }
#pragma unroll
      for (int f = 0; f < 2; ++f)
#pragma unroll
        for (int t = 0; t < 2; ++t) acc[f][t] = zero16();
      const int Kb = (br == 0) ? 512 : 256;
      const size_t woff = (br == 0) ? OFF_BRA : OFF_BRB + (size_t)(br - 1) * 1024 * 256;
      const int yoff = (br == 0) ? 0 : 512 + 256 * (br - 1);
      gemm_loop<2, 2, 4, 0>(p.Wt + woff + (size_t)f0 * Kb, Kb, p.Y + (size_t)tt * 256 * NY + yoff, NY, Kb, acc, lds);
#pragma unroll
      for (int f = 0; f < 2; ++f)
#pragma unroll
        for (int t = 0; t < 2; ++t)
#pragma unroll
          for (int j = 0; j < 8; ++j) {
            const unsigned u = gp[f][t][j];
            accM[f][t][2 * j] += __uint_as_float(u << 16) * acc[f][t][2 * j];
            accM[f][t][2 * j + 1] += __uint_as_float(u & 0xffff0000u) * acc[f][t][2 * j + 1];
          }
    }
#pragma unroll
    for (int f = 0; f < 2; ++f)
#pragma unroll
      for (int t = 0; t < 2; ++t) {
        const int token = tt * 256 + (wt * 2 + t) * 32 + r;
#pragma unroll
        for (int g4 = 0; g4 < 4; ++g4) {
          u32x2 w; w[0] = pk2(accM[f][t][4 * g4], accM[f][t][4 * g4 + 1]); w[1] = pk2(accM[f][t][4 * g4 + 2], accM[f][t][4 * g4 + 3]);
          *(u32x2*)(merged + (size_t)token * D + f0 + (wf * 2 + f) * 32 + 8 * g4 + 4 * hh) = w;
        }
      }
  }
}

template <int VAR, int DV>
DI void attn_core(const P& p, int b, int q0, int qoff, int koff, int vf0, int hfox, char* lds, f32x16 (&O)[DV / 32], float& lsum) {
  const int tid = TID(), lane = tid & 63, wave = tid >> 6, r = lane & 31, hh = lane >> 5;
  char* Kt = lds; char* Vt = lds + 64 * ROWB; float* cumt = (float*)(lds + 64 * ROWB + DV * ROWB);
  const int qw = q0 + wave * 32, query = qw + r;
  constexpr float SC2 = 0.125f * LOG2E;
  bf16x8 qf[4];
  {
    const u16* qp = p.PR + (size_t)(b * S + query) * NPR + qoff;
#pragma unroll
    for (int ks = 0; ks < 4; ++ks) qf[ks] = *(const bf16x8*)(qp + ks * 16 + hh * 8);
  }
#pragma unroll
  for (int db = 0; db < DV / 32; ++db) O[db] = zero16();
  float m = -INFINITY, l = 0.f, R = (VAR == 2) ? 1.f : 0.f, cq = 0.f;
  if (VAR == 1) cq = p.CUM[(size_t)(b * 4 + hfox) * S + query];
  const float cq2 = cq * LOG2E;
  const int nkt = q0 / 64 + 4;
  u32x4 rk[1], rv[DV / 64]; float rc = 0.f; u32x2 rm = {0u, 0u};
  auto prefetch = [&](int kt) {
    const int kb = kt * 64;
    {
      const int row = tid >> 3, kc = tid & 7;
      rk[0] = *(const u32x4*)(p.PR + (size_t)(b * S + kb + row) * NPR + koff + kc * 8);
    }
#pragma unroll
    for (int i = 0; i < DV / 64; ++i) {
      const int c = tid + 512 * i, row = c >> 3, kc = c & 7;
      rv[i] = *(const u32x4*)(p.VT + ((size_t)(b * NV + vf0 + row)) * S + kb + kc * 8);
    }
    if (VAR == 1) { if (tid < 64) rc = p.CUM[(size_t)(b * 4 + hfox) * S + kb + tid]; }
    if (VAR == 3) rm = *(const u32x2*)(p.MASK + (size_t)(b * S + query) * 128 + kt * 2);
  };
  prefetch((VAR == 2) ? (nkt - 1) : 0);
  for (int it = 0; it < nkt; ++it) {
    const int kt = (VAR == 2) ? (nkt - 1 - it) : it;
    const int kb = kt * 64;
    __syncthreads();
    {
      const int row = tid >> 3, kc = tid & 7;
      *(u32x4*)(Kt + row * ROWB + kc * 16) = rk[0];
    }
#pragma unroll
    for (int i = 0; i < DV / 64; ++i) {
      const int c = tid + 512 * i, row = c >> 3, kc = c & 7;
      *(u32x4*)(Vt + row * ROWB + kc * 16) = rv[i];
    }
    if (VAR == 1) { if (tid < 64) cumt[tid] = rc * LOG2E; }
    const u32x2 mw = rm;
    __syncthreads();
    if (it + 1 < nkt) prefetch((VAR == 2) ? (kt - 1) : (kt + 1));
#pragma unroll
    for (int ss = 0; ss < 2; ++ss) {
      const int sub = (VAR == 2) ? 1 - ss : ss;
      const int kb2 = kb + sub * 32;
      if (kb2 > qw + 31) continue;
      f32x16 sacc = zero16();
#pragma unroll
      for (int ks = 0; ks < 4; ++ks) {
        bf16x8 a = *(const bf16x8*)(Kt + (sub * 32 + r) * ROWB + ks * 32 + hh * 16);
        sacc = mfma(a, qf[ks], sacc);
      }
      float pv[16];
      if (VAR != 2) {
        const unsigned w = sub ? mw[1] : mw[0];
        const f32x16 sc = sacc;
#pragma unroll
        for (int i = 0; i < 16; ++i) {
          float sv = sc[i];
          if (VAR == 1) sv += cq2 - cumt[sub * 32 + crow(i, hh)];
          pv[i] = sv;
        }
        if (VAR == 3) {
#pragma unroll
          for (int i = 0; i < 16; ++i) pv[i] = (((w >> crow(i, hh)) & 1u) != 0u) ? pv[i] : -INFINITY;
        } else if (kb2 + 31 > qw) {
#pragma unroll
          for (int i = 0; i < 16; ++i) pv[i] = (kb2 + crow(i, hh) <= query) ? pv[i] : -INFINITY;
        }
        float mx = pv[0];
#pragma unroll
        for (int i = 1; i < 16; ++i) mx = fmaxf(mx, pv[i]);
        mx = xmax32(mx);
        const float mn = fmaxf(m, mx);
        const float mu = (mn == -INFINITY) ? 0.f : mn;
        if (__any(mn != m)) {
          const float alpha = __builtin_amdgcn_exp2f(m - mu);
          l *= alpha;
#pragma unroll
          for (int db = 0; db < DV / 32; ++db) O[db] = O[db] * alpha;
          m = mn;
        }
        float ps = 0.f;
#pragma unroll
        for (int i = 0; i < 16; ++i) { pv[i] = __builtin_amdgcn_exp2f(pv[i] - mu); ps += pv[i]; }
        l += xsum32(ps);
      } else {
        float bt[16], om[16];
#pragma unroll
        for (int i = 0; i < 16; ++i) {
          const float zc = fmaxf(sacc[i], -115.f);
          const float e = __builtin_amdgcn_exp2f(-zc);
          const float bb = __builtin_amdgcn_rcpf(1.f + e);
          bt[i] = bb;
          om[i] = e * bb;
        }
        if (kb2 + 31 >= qw) {
#pragma unroll
          for (int i = 0; i < 16; ++i) {
            const bool strict = (kb2 + crow(i, hh)) < query;
            bt[i] = strict ? bt[i] : 0.f;
            om[i] = strict ? om[i] : 1.f;
          }
        }
        float go[4], gx[4];
#pragma unroll
        for (int mm = 0; mm < 4; ++mm) go[mm] = (om[4 * mm] * om[4 * mm + 1]) * (om[4 * mm + 2] * om[4 * mm + 3]);
#pragma unroll
        for (int mm = 0; mm < 4; ++mm) gx[mm] = xoth32(go[mm], hh);
        float tail = 1.f;
#pragma unroll
        for (int mm = 3; mm >= 0; --mm) {
          const float later = tail * (hh == 0 ? gx[mm] : 1.f);
          const float a3 = R * later;
          const float a2 = a3 * om[4 * mm + 3];
          const float a1 = a2 * om[4 * mm + 2];
          const float a0 = a1 * om[4 * mm + 1];
          pv[4 * mm + 3] = bt[4 * mm + 3] * a3;
          pv[4 * mm + 2] = bt[4 * mm + 2] * a2;
          pv[4 * mm + 1] = bt[4 * mm + 1] * a1;
          pv[4 * mm + 0] = bt[4 * mm + 0] * a0;
          tail *= go[mm] * gx[mm];
        }
        R *= tail;
      }
      bf16x8 pf[2];
#pragma unroll
      for (int s2 = 0; s2 < 2; ++s2) {
        u32x4 u;
#pragma unroll
        for (int j = 0; j < 4; ++j) u[j] = pk2(pv[8 * s2 + 2 * j], pv[8 * s2 + 2 * j + 1]);
        pf[s2] = __builtin_bit_cast(bf16x8, u);
      }
#pragma unroll
      for (int db = 0; db < DV / 32; ++db)
#pragma unroll
        for (int s2 = 0; s2 < 2; ++s2) {
          const char* vp = Vt + (db * 32 + r) * ROWB + (sub * 32 + 16 * s2 + 4 * hh) * 2;
          u32x2 lo = *(const u32x2*)vp, hi = *(const u32x2*)(vp + 16);
          u32x4 u; u[0] = lo[0]; u[1] = lo[1]; u[2] = hi[0]; u[3] = hi[1];
          O[db] = mfma(__builtin_bit_cast(bf16x8, u), pf[s2], O[db]);
        }
    }
  }
  lsum = l;
}

template <int DV>
DI void store_y(const P& p, int b, int q0, int ycol, const f32x16 (&O)[DV / 32]) {
  const int lane = TID() & 63, wave = TID() >> 6, r = lane & 31, hh = lane >> 5;
  const int token = b * S + q0 + wave * 32 + r;
#pragma unroll
  for (int db = 0; db < DV / 32; ++db)
#pragma unroll
    for (int g4 = 0; g4 < 4; ++g4) {
      u32x2 w; w[0] = pk2(O[db][4 * g4], O[db][4 * g4 + 1]); w[1] = pk2(O[db][4 * g4 + 2], O[db][4 * g4 + 3]);
      *(u32x2*)(p.Y + (size_t)token * NY + ycol + db * 32 + 8 * g4 + 4 * hh) = w;
    }
}

DI void attn_task_diff(const P& p, int l, int b, int h, int q0, char* lds) {
  const int lane = TID() & 63, hh = lane >> 5;
  const float* lq1 = p.in[8] + l * 64; const float* lk1 = p.in[9] + l * 64;
  const float* lq2 = p.in[10] + l * 64; const float* lk2 = p.in[11] + l * 64;
  float d1 = 0.f, d2 = 0.f;
  for (int i = 0; i < 64; ++i) { d1 += lq1[i] * lk1[i]; d2 += lq2[i] * lk2[i]; }
  const float lam_init = 0.8f - 0.6f * expf(-0.3f * (float)l);
  const float lam = expf(d1) - expf(d2) + lam_init;
  f32x16 O1[4], O2[4]; float l1, l2;
  attn_core<0, 128>(p, b, q0, AQ + h * 128, AK + h * 128, h * 128, 0, lds, O1, l1);
  const float i1 = 1.f / l1;
#pragma unroll
  for (int db = 0; db < 4; ++db)
#pragma unroll
    for (int i = 0; i < 16; ++i) O1[db][i] *= i1;
  attn_core<0, 128>(p, b, q0, AQ + h * 128 + 64, AK + h * 128 + 64, h * 128, 0, lds, O2, l2);
  const float i2 = lam / l2;
  float ss = 0.f;
#pragma unroll
  for (int db = 0; db < 4; ++db)
#pragma unroll
    for (int i = 0; i < 16; ++i) { const float v = O1[db][i] - i2 * O2[db][i]; O1[db][i] = v; ss += v * v; }
  ss = xsum32(ss);
  const float rs = rsqrtf(ss * (1.f / 128.f) + 1e-5f) * (1.f - lam_init);
  const float* dg = p.in[12] + l * 128;
#pragma unroll
  for (int db = 0; db < 4; ++db)
#pragma unroll
    for (int i = 0; i < 16; ++i) O1[db][i] *= rs * dg[db * 32 + crow(i, hh)];
  store_y<128>(p, b, q0, h * 128, O1);
}
template <int VAR>
DI void attn_task_64(const P& p, int b, int h, int q0, char* lds) {
  f32x16 O[2]; float ls;
  constexpr int qo = (VAR == 1) ? BQ : (VAR == 2 ? CQ : DQ);
  constexpr int ko = (VAR == 1) ? BKo : (VAR == 2 ? CK : DK);
  constexpr int vo = (VAR == 1) ? 512 : (VAR == 2 ? 768 : 1024);
  attn_core<VAR, 64>(p, b, q0, qo + h * 64, ko + h * 64, vo + h * 64, h, lds, O, ls);
  if (VAR != 2) {
    const float il = 1.f / ls;
#pragma unroll
    for (int db = 0; db < 2; ++db)
#pragma unroll
      for (int i = 0; i < 16; ++i) O[db][i] *= il;
  }
  store_y<64>(p, b, q0, vo + h * 64, O);
}

DI void idx_task(const P& p, int b, int t0, char* lds) {
  float* sc = (float*)lds;
  const int tid = TID(), lane = tid & 63, wave = tid >> 6, r = lane & 31, hh = lane >> 5;
  __syncthreads();
  bf16x8 afA[4], afB[4];
  {
    const u16* ap = p.PR + (size_t)(b * S + t0 + (r >> 3)) * NPR + IQ + (r & 7) * 64;
#pragma unroll
    for (int ks = 0; ks < 4; ++ks) { afA[ks] = *(const bf16x8*)(ap + ks * 16 + hh * 8); afB[ks] = *(const bf16x8*)(ap + (size_t)4 * NPR + ks * 16 + hh * 8); }
  }
  float iwA[16], iwB[16];
#pragma unroll
  for (int i = 0; i < 16; ++i) {
    iwA[i] = p.IW[(size_t)(b * S + t0 + (i >> 2)) * 8 + (i & 3) + 4 * hh];
    iwB[i] = p.IW[(size_t)(b * S + t0 + 4 + (i >> 2)) * 8 + (i & 3) + 4 * hh];
  }
  const int ntile = (t0 + 7) / 32 + 1;
  for (int tb = wave * 4; tb < ntile; tb += 32) {
    bf16x8 bb[4][4];
#pragma unroll
    for (int u = 0; u < 4; ++u) {
      const int tile = min(tb + u, ntile - 1);
      const u16* bp = p.PR + (size_t)(b * S + tile * 32 + r) * NPR + IK;
#pragma unroll
      for (int ks = 0; ks < 4; ++ks) bb[u][ks] = *(const bf16x8*)(bp + ks * 16 + hh * 8);
    }
#pragma unroll
    for (int u = 0; u < 4; ++u) {
      const int tile = tb + u;
      f32x16 accA = zero16(), accB = zero16();
#pragma unroll
      for (int ks = 0; ks < 4; ++ks) { accA = mfma(afA[ks], bb[u][ks], accA); accB = mfma(afB[ks], bb[u][ks], accB); }
      float sA[4], sB[4];
#pragma unroll
      for (int q = 0; q < 4; ++q) {
        float va = 0.f, vb = 0.f;
#pragma unroll
        for (int j = 0; j < 4; ++j) { va += fmaxf(accA[4 * q + j], 0.f) * iwA[4 * q + j]; vb += fmaxf(accB[4 * q + j], 0.f) * iwB[4 * q + j]; }
        sA[q] = xsum32(va); sB[q] = xsum32(vb);
      }
      if (tile < ntile) {
        sc[(2 * hh) * 4096 + tile * 32 + r] = hh ? sA[2] : sA[0];
        sc[(2 * hh + 1) * 4096 + tile * 32 + r] = hh ? sA[3] : sA[1];
        sc[(4 + 2 * hh) * 4096 + tile * 32 + r] = hh ? sB[2] : sB[0];
        sc[(5 + 2 * hh) * 4096 + tile * 32 + r] = hh ? sB[3] : sB[1];
      }
    }
  }
  __syncthreads();
  const int t = __builtin_amdgcn_readfirstlane(t0 + wave);
  unsigned key[64];
#pragma unroll
  for (int c = 0; c < 64; ++c) {
    const int s = c * 64 + lane;
    unsigned u = __float_as_uint(sc[wave * 4096 + s]);
    u = (u & 0x80000000u) ? ~u : (u | 0x80000000u);
    key[c] = (s <= t) ? u : 0u;
  }
  u64 mymask = 0;
  const int nch = (t >> 6) + 1;
  if (t >= 256) {
    unsigned T = 0;
    bool exact = false;
    for (int bit = 31; bit >= 0; --bit) {
      const unsigned cand = T | (1u << bit);
      int cl = 0;
#pragma unroll
      for (int g = 0; g < 8; ++g) {
        if (g * 8 < nch) {
#pragma unroll
          for (int c = g * 8; c < g * 8 + 8; ++c) cl += (key[c] >= cand) ? 1 : 0;
        }
      }
      const int cnt = wave_sum_i32(cl);
      if (cnt >= 256) T = cand;
      if (cnt == 256) { exact = true; break; }
    }
    if (exact) {
#pragma unroll
      for (int c = 0; c < 64; ++c) {
        const u64 mk = __ballot(key[c] >= T);
        if (lane == c) mymask = mk;
      }
    } else {
    int ngt = 0;
#pragma unroll
    for (int c = 0; c < 64; ++c) ngt += __popcll(__ballot(key[c] > T));
    int rem = 256 - ngt;
#pragma unroll
    for (int c = 0; c < 64; ++c) {
      const u64 gt = __ballot(key[c] > T);
      u64 eq = __ballot(key[c] == T);
      int e = __popcll(eq);
      while (e > rem) { eq &= ~(1ull << (63 - __clzll(eq))); --e; }
      rem -= e;
      const u64 mk = gt | eq;
      if (lane == c) mymask = mk;
    }
    }
  } else {
#pragma unroll
    for (int c = 0; c < 64; ++c) {
      const u64 mk = __ballot(c * 64 + lane <= t);
      if (lane == c) mymask = mk;
    }
  }
  *(u64*)(p.MASK + (size_t)(b * S + t) * 128 + lane * 2) = mymask;
}

DI void scan_task(const P& p, int pair) {
  const int lane = TID() & 63;
  const int b = pair >> 2, h = pair & 3;
  const float* src = p.FL + ((size_t)(b * S + lane * 64)) * 4 + h;
  float v[64];
#pragma unroll
  for (int j = 0; j < 64; ++j) v[j] = src[j * 4];
#pragma unroll
  for (int j = 1; j < 64; ++j) v[j] += v[j - 1];
  float tot = v[63], inc = tot;
#pragma unroll
  for (int o = 1; o < 64; o <<= 1) { const float u = __shfl_up(inc, o); if (lane >= o) inc += u; }
  const float off = inc - tot;
  float* dst = p.CUM + (size_t)pair * S + lane * 64;
#pragma unroll
  for (int j = 0; j < 64; j += 4) {
    f32x4 o4; o4[0] = v[j] + off; o4[1] = v[j + 1] + off; o4[2] = v[j + 2] + off; o4[3] = v[j + 3] + off;
    *(f32x4*)(dst + j) = o4;
  }
}

DI int zz_id(int r) { const int G = gridDim.x, bb = blockIdx.x; return r * G + ((r & 1) ? (G - 1 - bb) : bb); }
DI bool attn_map(int r, int& bh, int& qt) {
  if (gridDim.x == 256) {
    if (r >= 2) return false;
    const int x = blockIdx.x & 7, jb = blockIdx.x >> 3;
    bh = 4 * x + (jb >> 3);
    qt = (r == 0) ? 15 - (jb & 7) : (jb & 7);
    return true;
  }
  if (r * (int)gridDim.x >= 512) return false;
  const int id = zz_id(r);
  if (id >= 512) { bh = -1; return true; }
  bh = id & 31; qt = 15 - (id >> 5);
  return true;
}
DI void phase_mix1(const P& p, int l, char* lds) {
  for (int task = blockIdx.x; task < 4; task += gridDim.x) scan_task(p, task * 8 + (TID() >> 6));
  for (int r = 0; r * (int)gridDim.x < 4096; ++r) {
    const int id = zz_id(r); if (id >= 4096) continue;
    const int trev = id >> 3, b = id & 7;
    idx_task(p, b, (511 - trev) * 8, lds);
  }
  int bh, qt;
  for (int r = 0; attn_map(r, bh, qt); ++r) { if (bh >= 0) attn_task_diff(p, l, bh >> 2, bh & 3, qt * 256, lds); }
  for (int r = 0; attn_map(r, bh, qt); ++r) { if (bh >= 0) attn_task_64<2>(p, bh >> 2, bh & 3, qt * 256, lds); }
}
DI void phase_mix2(const P& p, char* lds) {
  int bh, qt;
  for (int r = 0; attn_map(r, bh, qt); ++r) { if (bh >= 0) attn_task_64<1>(p, bh >> 2, bh & 3, qt * 256, lds); }
  for (int r = 0; attn_map(r, bh, qt); ++r) { if (bh >= 0) attn_task_64<3>(p, bh >> 2, bh & 3, qt * 256, lds); }
}

__global__ void __launch_bounds__(512, 2) mega_kernel(P p) {
  __shared__ __attribute__((aligned(16))) char lds[LDS_BYTES];
  cg::grid_group grid = cg::this_grid();
  u16* act = p.PR; u16* merged = p.PR;
  for (int l = 0; l < 2; ++l) {
    const float* xcur = (l == 0) ? p.in[0] : p.xres;
    phase_conv(p, l, lds); phase_norm(xcur, p.in[2] + l * D, p.hb); grid.sync();
    phase_gu(p, p.Wt + OFF_GU1, act, lds); grid.sync();
    phase_resid(p.Wt + OFF_DN1, act, DFF, xcur, p.xres, 0.5f, lds); grid.sync();
    phase_norm(p.xres, p.in[5] + l * D, p.hb); grid.sync();
    phase_proj(p, l, lds); grid.sync();
    phase_mix1(p, l, lds); grid.sync();
    phase_mix2(p, lds); grid.sync();
    phase_merge(p, l, merged, lds); grid.sync();
    phase_resid(p.Wt + OFF_OUT, merged, D, p.xres, p.xres, 1.0f, lds); grid.sync();
    phase_norm(p.xres, p.in[20] + l * D, p.hb); grid.sync();
    phase_gu(p, p.Wt + OFF_GU2, act, lds); grid.sync();
    phase_resid(p.Wt + OFF_DN2, act, DFF, p.xres, p.xres, 0.5f, lds); grid.sync();
  }
  phase_final_norm(p.xres, p.in[23]);
}

extern "C" void kernel_launch(void* const* d_in, const int* in_sizes, int n_in, void* d_out, int out_size, void* d_ws, size_t ws_size, hipStream_t stream) {
  P p{};
  for (int i = 0; i < 24; ++i) p.in[i] = (const float*)d_in[i];
  p.pos = (const int*)d_in[1];
  p.xres = (float*)d_out;
  char* w = (char*)d_ws; size_t off = 0;
  auto take = [&](size_t bytes) { char* r = w + off; off += (bytes + 255) & ~(size_t)255; return r; };
  p.Wt = (u16*)take(WT_ELEMS * 2);
  p.hb = (u16*)take((size_t)M * D * 2);
  p.PR = (u16*)take((size_t)M * NPR * 2);
  p.VT = (u16*)take((size_t)NB * NV * S * 2);
  p.Y = (u16*)take((size_t)M * NY * 2);
  p.MASK = (unsigned*)take((size_t)M * 128 * 4);
  p.FL = (float*)take((size_t)M * 4 * 4);
  p.IW = (float*)take((size_t)M * 8 * 4);
  p.CUM = (float*)take((size_t)M * 4 * 4);
  p.COS = (float*)take((size_t)S * 8 * 4);
  p.SIN = (float*)take((size_t)S * 8 * 4);
  if (off > ws_size) { fprintf(stderr, "workspace too small: need %zu have %zu\n", off, ws_size); return; }
  static int grid_blocks = 0;
  if (!grid_blocks) {
    int dev = 0, cus = 0, per_cu = 0;
    hipGetDevice(&dev);
    hipDeviceGetAttribute(&cus, hipDeviceAttributeMultiprocessorCount, dev);
    hipOccupancyMaxActiveBlocksPerMultiprocessor(&per_cu, mega_kernel, 512, 0);
    grid_blocks = cus * (per_cu < 1 ? 1 : per_cu);
  }
  void* args[] = {&p};
  hipError_t e = hipLaunchCooperativeKernel((void*)mega_kernel, dim3(grid_blocks), dim3(512), args, 0, stream);
  if (e != hipSuccess) fprintf(stderr, "cooperative launch failed: %s (grid %d)\n", hipGetErrorString(e), grid_blocks);
}
```

```cpp
#include <hip/hip_runtime.h>
#include <hip/hip_cooperative_groups.h>
#include <cstdio>
namespace cg = cooperative_groups;

#define DI __device__ __forceinline__
typedef unsigned short u16;
typedef unsigned long long u64;
typedef __attribute__((ext_vector_type(8))) short bf16x8;
typedef __attribute__((ext_vector_type(16))) float f32x16;
typedef __attribute__((ext_vector_type(4))) float f32x4;
typedef __attribute__((ext_vector_type(2))) float f32x2;
typedef __attribute__((ext_vector_type(2))) __bf16 bf2;
typedef __attribute__((ext_vector_type(4))) unsigned u32x4;
typedef __attribute__((ext_vector_type(2))) unsigned u32x2;

constexpr int D = 1024, NB = 8, S = 4096, M = NB * S, DFF = 2816;
constexpr int NPR = 3200, NV = 1280, NY = 1280;
constexpr int AQ = 0, AK = 512, BQ = 1024, BKo = 1280, CQ = 1536, CK = 1792, DQ = 2048, DK = 2304, IQ = 2560, IK = 3072, SMALL = 3136;
constexpr size_t OFF_GU1 = 0;
constexpr size_t OFF_DN1 = OFF_GU1 + (size_t)5632 * 1024;
constexpr size_t OFF_IN = OFF_DN1 + (size_t)1024 * 2816;
constexpr size_t OFF_GATE = OFF_IN + (size_t)4608 * 1024;
constexpr size_t OFF_BRA = OFF_GATE + (size_t)4096 * 1024;
constexpr size_t OFF_BRB = OFF_BRA + (size_t)1024 * 512;
constexpr size_t OFF_BRC = OFF_BRB + (size_t)1024 * 256;
constexpr size_t OFF_BRD = OFF_BRC + (size_t)1024 * 256;
constexpr size_t OFF_OUT = OFF_BRD + (size_t)1024 * 256;
constexpr size_t OFF_GU2 = OFF_OUT + (size_t)1024 * 1024;
constexpr size_t OFF_DN2 = OFF_GU2 + (size_t)5632 * 1024;
constexpr size_t WT_ELEMS = OFF_DN2 + (size_t)1024 * 2816;

constexpr float LOG2E = 1.4426950408889634f;
constexpr int LDS_BYTES = 131072;
constexpr int ROWB = 144;

struct P {
  const float* in[24];
  const int* pos;
  float* xres;
  u16* Wt; u16* hb; u16* PR; u16* VT; u16* Y;
  unsigned* MASK; float* FL; float* IW; float* CUM; float* COS; float* SIN;
};

DI int TID() { int t = (int)__builtin_amdgcn_workitem_id_x(); asm volatile("" : "+v"(t)); return t; }
DI unsigned pk2(float a, float b) { f32x2 v = {a, b}; bf2 r = __builtin_convertvector(v, bf2); return __builtin_bit_cast(unsigned, r); }
DI u16 f2bf(float a) { __bf16 h = (__bf16)a; return __builtin_bit_cast(u16, h); }
DI float wsum(float v) {
#pragma unroll
  for (int o = 32; o > 0; o >>= 1) v += __shfl_xor(v, o);
  return v;
}
DI float xmax32(float x) { auto r2 = __builtin_amdgcn_permlane32_swap(__float_as_uint(x), __float_as_uint(x), false, false); return fmaxf(__uint_as_float(r2[0]), __uint_as_float(r2[1])); }
DI float xsum32(float x) { auto r2 = __builtin_amdgcn_permlane32_swap(__float_as_uint(x), __float_as_uint(x), false, false); return __uint_as_float(r2[0]) + __uint_as_float(r2[1]); }
DI float xoth32(float x, int hh) { auto r2 = __builtin_amdgcn_permlane32_swap(__float_as_uint(x), __float_as_uint(x), false, false); return __uint_as_float(hh ? r2[0] : r2[1]); }
DI int wave_sum_i32(int v) {
  v += __builtin_amdgcn_update_dpp(0, v, 0xB1, 0xf, 0xf, false);
  v += __builtin_amdgcn_update_dpp(0, v, 0x4E, 0xf, 0xf, false);
  v += __builtin_amdgcn_update_dpp(0, v, 0x141, 0xf, 0xf, false);
  v += __builtin_amdgcn_update_dpp(0, v, 0x140, 0xf, 0xf, false);
  v += __builtin_amdgcn_update_dpp(0, v, 0x142, 0xa, 0xf, false);
  v += __builtin_amdgcn_update_dpp(0, v, 0x143, 0xc, 0xf, false);
  return __builtin_amdgcn_readlane(v, 63);
}
DI constexpr int crow(int i, int hh) { return (i & 3) + 8 * (i >> 2) + 4 * hh; }
DI f32x16 mfma(bf16x8 a, bf16x8 b, f32x16 c) { return __builtin_amdgcn_mfma_f32_32x32x16_bf16(a, b, c, 0, 0, 0); }
DI f32x16 zero16() { f32x16 z;
#pragma unroll
  for (int i = 0; i < 16; ++i) z[i] = 0.f; return z; }

DI void phase_norm(const float* __restrict__ src, const float* __restrict__ g, u16* __restrict__ dst) {
  const int lane = TID() & 63;
  const int wave = (blockIdx.x * 512 + TID()) >> 6, nw = gridDim.x * 8;
  for (int row = wave; row < M; row += nw) {
    const f32x4* p = (const f32x4*)(src + (size_t)row * D);
    f32x4 v[4]; float ss = 0.f;
#pragma unroll
    for (int j = 0; j < 4; ++j) { v[j] = __builtin_nontemporal_load(p + lane + 64 * j); ss += v[j][0] * v[j][0] + v[j][1] * v[j][1] + v[j][2] * v[j][2] + v[j][3] * v[j][3]; }
    ss = wsum(ss);
    const float rs = rsqrtf(ss * (1.f / D) + 1e-6f);
#pragma unroll
    for (int j = 0; j < 4; ++j) {
      f32x4 gg = ((const f32x4*)g)[lane + 64 * j];
      u32x2 o; o[0] = pk2(v[j][0] * rs * gg[0], v[j][1] * rs * gg[1]); o[1] = pk2(v[j][2] * rs * gg[2], v[j][3] * rs * gg[3]);
      *(u32x2*)(dst + (size_t)row * D + (lane + 64 * j) * 4) = o;
    }
  }
}
DI void phase_final_norm(float* __restrict__ x, const float* __restrict__ g) {
  const int lane = TID() & 63;
  const int wave = (blockIdx.x * 512 + TID()) >> 6, nw = gridDim.x * 8;
  for (int row = wave; row < M; row += nw) {
    f32x4* p = (f32x4*)(x + (size_t)row * D);
    f32x4 v[4]; float ss = 0.f;
#pragma unroll
    for (int j = 0; j < 4; ++j) { v[j] = p[lane + 64 * j]; ss += v[j][0] * v[j][0] + v[j][1] * v[j][1] + v[j][2] * v[j][2] + v[j][3] * v[j][3]; }
    ss = wsum(ss);
    const float rs = rsqrtf(ss * (1.f / D) + 1e-6f);
#pragma unroll
    for (int j = 0; j < 4; ++j) {
      f32x4 gg = ((const f32x4*)g)[lane + 64 * j];
      f32x4 o; o[0] = v[j][0] * rs * gg[0]; o[1] = v[j][1] * rs * gg[1]; o[2] = v[j][2] * rs * gg[2]; o[3] = v[j][3] * rs * gg[3];
      p[lane + 64 * j] = o;
    }
  }
}

DI int map_gu(int n) { int c = (n < DFF) ? n : n - DFF; return (c >> 5) * 64 + (c & 31) + ((n < DFF) ? 0 : 32); }
DI int map_in(int n) {
  if (n < 512) return n;
  if (n < 1024) return n;
  if (n < 1536) return n - 1024 + 3200;
  if (n < 1792) return n - 1536 + BQ;
  if (n < 2048) return n - 1792 + BKo;
  if (n < 2304) return n - 2048 + 3200 + 512;
  if (n < 2308) return n - 2304 + SMALL;
  if (n < 2564) return n - 2308 + CQ;
  if (n < 2820) return n - 2564 + CK;
  if (n < 3076) return n - 2820 + 3200 + 768;
  if (n < 3332) return n - 3076 + DQ;
  if (n < 3588) return n - 3332 + DK;
  if (n < 3844) return n - 3588 + 3200 + 1024;
  if (n < 4356) return n - 3844 + IQ;
  if (n < 4420) return n - 4356 + IK;
  return n - 4420 + SMALL + 4;
}
DI void conv_w(const float* __restrict__ W, int K, int N, u16* __restrict__ Wt, int mp, char* lds) {
  const int tid = TID(), half = tid >> 8, t8 = tid & 255, tn = t8 & 15, tk = t8 >> 4;
  char* my = lds + half * (64 * ROWB);
  const int ntn = (N + 63) >> 6, ntk = K >> 6, ntile = ntn * ntk;
  for (int base = 2 * blockIdx.x; base < ntile; base += 2 * gridDim.x) {
    const int tile = base + half;
    const bool on = tile < ntile;
    const int n0 = (tile % ntn) * 64, k0 = (tile / ntn) * 64;
    f32x4 v[4];
    const int n = n0 + 4 * tn;
#pragma unroll
    for (int i = 0; i < 4; ++i) {
      if (on && n < N) v[i] = __builtin_nontemporal_load((const f32x4*)(W + (size_t)(k0 + 4 * tk + i) * N + n));
      else { v[i][0] = 0.f; v[i][1] = 0.f; v[i][2] = 0.f; v[i][3] = 0.f; }
    }
    __syncthreads();
#pragma unroll
    for (int j = 0; j < 4; ++j) {
      u32x2 w; w[0] = pk2(v[0][j], v[1][j]); w[1] = pk2(v[2][j], v[3][j]);
      *(u32x2*)(my + (4 * tn + j) * ROWB + tk * 8) = w;
    }
    __syncthreads();
#pragma unroll
    for (int ps = 0; ps < 2; ++ps) {
      const int nn = (t8 >> 3) + 32 * ps, c = t8 & 7, ng = n0 + nn;
      if (on && ng < N) {
        const int np = (mp == 0) ? ng : (mp == 1 ? map_gu(ng) : map_in(ng));
        *(u32x4*)(Wt + (size_t)np * K + k0 + 8 * c) = *(const u32x4*)(my + nn * ROWB + c * 16);
      }
    }
  }
}
DI void phase_conv(const P& p, int l, char* lds) {
  conv_w(p.in[3] + (size_t)l * 1024 * 5632, 1024, 5632, p.Wt + OFF_GU1, 1, lds);
  conv_w(p.in[4] + (size_t)l * 2816 * 1024, 2816, 1024, p.Wt + OFF_DN1, 0, lds);
  conv_w(p.in[6] + (size_t)l * 1024 * 4428, 1024, 4428, p.Wt + OFF_IN, 2, lds);
  conv_w(p.in[13] + (size_t)l * 1024 * 4096, 1024, 4096, p.Wt + OFF_GATE, 0, lds);
  conv_w(p.in[15] + (size_t)l * 512 * 1024, 512, 1024, p.Wt + OFF_BRA, 0, lds);
  conv_w(p.in[16] + (size_t)l * 256 * 1024, 256, 1024, p.Wt + OFF_BRB, 0, lds);
  conv_w(p.in[17] + (size_t)l * 256 * 1024, 256, 1024, p.Wt + OFF_BRC, 0, lds);
  conv_w(p.in[18] + (size_t)l * 256 * 1024, 256, 1024, p.Wt + OFF_BRD, 0, lds);
  conv_w(p.in[19] + (size_t)l * 1024 * 1024, 1024, 1024, p.Wt + OFF_OUT, 0, lds);
  conv_w(p.in[21] + (size_t)l * 1024 * 5632, 1024, 5632, p.Wt + OFF_GU2, 1, lds);
  conv_w(p.in[22] + (size_t)l * 2816 * 1024, 2816, 1024, p.Wt + OFF_DN2, 0, lds);
  const int gt = blockIdx.x * 512 + TID(), nt = gridDim.x * 512;
  for (int i = gt; i < 52 * 1024; i += nt) p.Wt[OFF_IN + (size_t)3148 * 1024 + i] = 0;
  for (int i = gt; i < 128 * 1024; i += nt) p.Wt[OFF_IN + (size_t)4480 * 1024 + i] = 0;
  if (l == 0) {
    for (int i = gt; i < S * 8; i += nt) {
      const int s = i >> 3, c = i & 7;
      const float freq = powf(500000.0f, -(float)(2 * c) / 16.0f);
      const float ang = (float)p.pos[s] * freq;
      p.COS[i] = cosf(ang); p.SIN[i] = sinf(ang);
    }
  }
}

#define LAS __attribute__((address_space(3)))
template <int WF, int WT, int WGT, int PF = 1>
DI void gemm_loop(const u16* __restrict__ A, size_t lda, const u16* __restrict__ B, size_t ldb, int K, f32x16 (&acc)[WF][WT], char* lds) {
  constexpr int WGF = 8 / WGT;
  constexpr int BF = 32 * WF * WGF, BT = 32 * WT * WGT;
  constexpr int ABYTES = BF * 128, BBYTES = BT * 128, STAGE = ABYTES + BBYTES;
  constexpr int IA = BF / 64, IB = BT / 64;
  static_assert(2 * STAGE <= LDS_BYTES, "lds");
  const int tid = TID(), lane = tid & 63, wave = tid >> 6;
  const int wf = wave / WGT, wt = wave % WGT, r = lane & 31, hh = lane >> 5;
  const int kcs = (tid & 7) ^ ((tid >> 4) & 7);
  const u16* ga = A + (size_t)(tid >> 3) * lda + kcs * 8;
  const u16* gb = B + (size_t)(tid >> 3) * ldb + kcs * 8;
  LAS char* l3 = (LAS char*)lds;
  const int sw = (r >> 1) & 7;
  __syncthreads();
#pragma unroll
  for (int i = 0; i < IA; ++i) __builtin_amdgcn_global_load_lds((const unsigned*)(ga + (size_t)i * 64 * lda), (LAS unsigned*)(l3 + i * 8192 + wave * 1024), 16, 0, 0);
#pragma unroll
  for (int i = 0; i < IB; ++i) __builtin_amdgcn_global_load_lds((const unsigned*)(gb + (size_t)i * 64 * ldb), (LAS unsigned*)(l3 + ABYTES + i * 8192 + wave * 1024), 16, 0, 0);
  const int nk = K >> 6;
  for (int kt = 0; kt < nk; ++kt) {
    __syncthreads();
    if (kt + 1 < nk) {
      const int nb = ((kt + 1) & 1) * STAGE, k0 = (kt + 1) * 64;
#pragma unroll
      for (int i = 0; i < IA; ++i) __builtin_amdgcn_global_load_lds((const unsigned*)(ga + (size_t)i * 64 * lda + k0), (LAS unsigned*)(l3 + nb + i * 8192 + wave * 1024), 16, 0, 0);
#pragma unroll
      for (int i = 0; i < IB; ++i) __builtin_amdgcn_global_load_lds((const unsigned*)(gb + (size_t)i * 64 * ldb + k0), (LAS unsigned*)(l3 + nb + ABYTES + i * 8192 + wave * 1024), 16, 0, 0);
    }
    const char* sa = lds + (kt & 1) * STAGE;
    const char* sb = sa + ABYTES;
    bf16x8 af[PF + 1][WF], bfr[PF + 1][WT];
    if (PF) {
      const int co = ((0 * 2 + hh) ^ sw) << 4;
#pragma unroll
      for (int f = 0; f < WF; ++f) af[0][f] = *(const bf16x8*)(sa + ((wf * WF + f) * 32 + r) * 128 + co);
#pragma unroll
      for (int t = 0; t < WT; ++t) bfr[0][t] = *(const bf16x8*)(sb + ((wt * WT + t) * 32 + r) * 128 + co);
    }
#pragma unroll
    for (int ks = 0; ks < 4; ++ks) {
      const int ld = PF ? ks + 1 : ks, li = PF ? ((ks + 1) & 1) : 0, ci = PF ? (ks & 1) : 0;
      if (ld < 4) {
        const int co = ((ld * 2 + hh) ^ sw) << 4;
#pragma unroll
        for (int f = 0; f < WF; ++f) af[li][f] = *(const bf16x8*)(sa + ((wf * WF + f) * 32 + r) * 128 + co);
#pragma unroll
        for (int t = 0; t < WT; ++t) bfr[li][t] = *(const bf16x8*)(sb + ((wt * WT + t) * 32 + r) * 128 + co);
      }
#pragma unroll
      for (int f = 0; f < WF; ++f)
#pragma unroll
        for (int t = 0; t < WT; ++t) acc[f][t] = mfma(af[ci][f], bfr[ci][t], acc[f][t]);
    }
    __syncthreads();
  }
}
DI bool tile_at(int round, int NF, int ntiles, int& ft, int& tt) {
  const int G8 = gridDim.x >> 3;
  const int L = (round * 8 + (int)(blockIdx.x & 7)) * G8 + (int)(blockIdx.x >> 3);
  if (L >= ntiles) return false;
  const int tg = L / (NF * 8), rem = L - tg * NF * 8;
  ft = rem >> 3; tt = tg * 8 + (rem & 7);
  return true;
}

DI void phase_gu(const P& p, const u16* __restrict__ Wt, u16* __restrict__ act, char* lds) {
  const int lane = TID() & 63, wave = TID() >> 6, wf = wave >> 2, wt = wave & 3, r = lane & 31, hh = lane >> 5;
  for (int rnd = 0; rnd * (int)gridDim.x < 22 * 128; ++rnd) {
    int ft, tt; if (!tile_at(rnd, 22, 22 * 128, ft, tt)) continue;
    f32x16 acc[4][2];
#pragma unroll
    for (int f = 0; f < 4; ++f)
#pragma unroll
      for (int t = 0; t < 2; ++t) acc[f][t] = zero16();
    gemm_loop<4, 2, 4>(Wt + (size_t)ft * 256 * 1024, 1024, p.hb + (size_t)tt * 256 * 1024, 1024, 1024, acc, lds);
#pragma unroll
    for (int t = 0; t < 2; ++t) {
      const int token = tt * 256 + (wt * 2 + t) * 32 + r;
#pragma unroll
      for (int pr = 0; pr < 2; ++pr) {
        const int c0 = ft * 128 + wf * 64 + pr * 32;
#pragma unroll
        for (int g4 = 0; g4 < 4; ++g4) {
          float o[4];
#pragma unroll
          for (int j = 0; j < 4; ++j) { const float g = acc[2 * pr][t][4 * g4 + j], u = acc[2 * pr + 1][t][4 * g4 + j]; o[j] = g * __builtin_amdgcn_rcpf(1.f + __builtin_amdgcn_exp2f(-LOG2E * g)) * u; }
          u32x2 w; w[0] = pk2(o[0], o[1]); w[1] = pk2(o[2], o[3]);
          *(u32x2*)(act + (size_t)token * DFF + c0 + 8 * g4 + 4 * hh) = w;
        }
      }
    }
  }
}
DI void phase_resid(const u16* __restrict__ Wt, const u16* __restrict__ B, int K, const float* __restrict__ xsrc, float* __restrict__ xout, float alpha, char* lds) {
  const int lane = TID() & 63, wave = TID() >> 6, wf = wave >> 2, wt = wave & 3, r = lane & 31, hh = lane >> 5;
  for (int rnd = 0; rnd * (int)gridDim.x < 4 * 128; ++rnd) {
    int ft, tt; if (!tile_at(rnd, 4, 4 * 128, ft, tt)) continue;
    f32x16 acc[4][2];
#pragma unroll
    for (int f = 0; f < 4; ++f)
#pragma unroll
      for (int t = 0; t < 2; ++t) acc[f][t] = zero16();
    gemm_loop<4, 2, 4>(Wt + (size_t)ft * 256 * K, K, B + (size_t)tt * 256 * K, K, K, acc, lds);
#pragma unroll
    for (int f = 0; f < 4; ++f)
#pragma unroll
      for (int t = 0; t < 2; ++t) {
        const int token = tt * 256 + (wt * 2 + t) * 32 + r;
        const int fb = ft * 256 + (wf * 4 + f) * 32;
#pragma unroll
        for (int g4 = 0; g4 < 4; ++g4) {
          const size_t off = (size_t)token * D + fb + 8 * g4 + 4 * hh;
          f32x4 xv = *(const f32x4*)(xsrc + off);
#pragma unroll
          for (int j = 0; j < 4; ++j) xv[j] += alpha * acc[f][t][4 * g4 + j];
          *(f32x4*)(xout + off) = xv;
        }
      }
  }
}
DI void phase_proj(const P& p, int l, char* lds) {
  const int lane = TID() & 63, wave = TID() >> 6, wf = wave >> 2, wt = wave & 3, r = lane & 31, hh = lane >> 5;
  const float* bf = p.in[7] + l * 4;
  for (int rnd = 0; rnd * (int)gridDim.x < 18 * 128; ++rnd) {
    int ft, tt; if (!tile_at(rnd, 18, 18 * 128, ft, tt)) continue;
    f32x16 acc[4][2];
#pragma unroll
    for (int f = 0; f < 4; ++f)
#pragma unroll
      for (int t = 0; t < 2; ++t) acc[f][t] = zero16();
    gemm_loop<4, 2, 4>(p.Wt + OFF_IN + (size_t)ft * 256 * 1024, 1024, p.hb + (size_t)tt * 256 * 1024, 1024, 1024, acc, lds);
#pragma unroll
    for (int f = 0; f < 4; ++f)
#pragma unroll
      for (int t = 0; t < 2; ++t) {
        const int token = tt * 256 + (wt * 2 + t) * 32 + r;
        const int fb = ft * 256 + (wf * 4 + f) * 32;
        const int sidx = token & (S - 1), b = token >> 12;
        if (fb < 3200) {
          const bool rope = ((fb & 63) == 0) && (fb < 1024 || (fb >= 2048 && fb < SMALL));
          if (rope) {
            const f32x4 cs = *(const f32x4*)(p.COS + sidx * 8 + 4 * hh);
            const f32x4 sn = *(const f32x4*)(p.SIN + sidx * 8 + 4 * hh);
#pragma unroll
            for (int j = 0; j < 4; ++j) {
              const float x1 = acc[f][t][j], x2 = acc[f][t][4 + j];
              acc[f][t][j] = x1 * cs[j] - x2 * sn[j];
              acc[f][t][4 + j] = x2 * cs[j] + x1 * sn[j];
            }
          }
          const bool isq = (fb < 512) || (fb >= BQ && fb < BKo) || (fb >= CQ && fb < CK) || (fb >= DQ && fb < DK);
          if (isq) acc[f][t] = acc[f][t] * (0.125f * LOG2E);
          if (fb == SMALL) {
            if (hh == 0) {
#pragma unroll
              for (int j = 0; j < 4; ++j) {
                const float z = acc[f][t][j] + bf[j];
                p.FL[(size_t)token * 4 + j] = fminf(z, 0.f) - __logf(1.f + __expf(-fabsf(z)));
                p.IW[(size_t)token * 8 + 4 + j] = acc[f][t][4 + j];
              }
            } else {
#pragma unroll
              for (int j = 0; j < 4; ++j) p.IW[(size_t)token * 8 + j] = acc[f][t][j];
            }
          }
#pragma unroll
          for (int g4 = 0; g4 < 4; ++g4) {
            u32x2 w; w[0] = pk2(acc[f][t][4 * g4], acc[f][t][4 * g4 + 1]); w[1] = pk2(acc[f][t][4 * g4 + 2], acc[f][t][4 * g4 + 3]);
            *(u32x2*)(p.PR + (size_t)token * NPR + fb + 8 * g4 + 4 * hh) = w;
          }
        } else if (fb < 4480) {
          const int vf0 = fb - 3200;
#pragma unroll
          for (int i = 0; i < 16; ++i) p.VT[((size_t)(b * NV + vf0 + crow(i, hh))) * S + sidx] = f2bf(acc[f][t][i]);
        }
      }
  }
}
DI void phase_merge(const P& p, int l, u16* __restrict__ merged, char* lds) {
  const int lane = TID() & 63, wave = TID() >> 6, wf = wave >> 2, wt = wave & 3, r = lane & 31, hh = lane >> 5;
  const float* bg = p.in[14] + (size_t)l * 4096;
  for (int rnd = 0; rnd * (int)gridDim.x < 8 * 128; ++rnd) {
    int ft, tt; if (!tile_at(rnd, 8, 8 * 128, ft, tt)) continue;
    const int f0 = ft * 128;
    f32x16 accM[2][2];
#pragma unroll
    for (int f = 0; f < 2; ++f)
#pragma unroll
      for (int t = 0; t < 2; ++t) accM[f][t] = zero16();
    for (int br = 0; br < 4; ++br) {
      f32x16 acc[2][2];
#pragma unroll
      for (int f = 0; f < 2; ++f)
#pragma unroll
        for (int t = 0; t < 2; ++t) acc[f][t] = zero16();
      gemm_loop<2, 2, 4, 0>(p.Wt + OFF_GATE + (size_t)(br * 1024 + f0) * 1024, 1024, p.hb + (size_t)tt * 256 * 1024, 1024, 1024, acc, lds);
      unsigned gp[2][2][8];
      const int tq = TID(), wfq = tq >> 8, hq = (tq >> 5) & 1;
      const float* bq = bg + br * 1024 + f0 + wfq * 64 + 4 * hq;
#pragma unroll
      for (int f = 0; f < 2; ++f)
#pragma unroll
        for (int j = 0; j < 8; ++j) {
          const float b0 = bq[f * 32 + crow(2 * j, 0)];
          const float b1 = bq[f * 32 + crow(2 * j + 1, 0)];
#pragma unroll
          for (int t = 0; t < 2; ++t) {
            const float g0 = __builtin_amdgcn_rcpf(1.f + __builtin_amdgcn_exp2f(-LOG2E * (acc[f][t][2 * j] + b0)));
            const float g1 = __builtin_amdgcn_rcpf(1.f + __builtin_amdgcn_exp2f(-LOG2E * (acc[f][t][2 * j + 1] + b1)));
            gp[f][t][j] = pk2(g0, g1);
          }
        }
#pragma unroll
      for (int f = 0; f < 2; ++f)
#pragma unroll
        for (int t = 0; t < 2; ++t) acc[f][t] = zero16();
      const int Kb = (br == 0) ? 512 : 256;
      const size_t woff = (br == 0) ? OFF_BRA : OFF_BRB + (size_t)(br - 1) * 1024 * 256;
      const int yoff = (br == 0) ? 0 : 512 + 256 * (br - 1);
      gemm_loop<2, 2, 4, 0>(p.Wt + woff + (size_t)f0 * Kb, Kb, p.Y + (size_t)tt * 256 * NY + yoff, NY, Kb, acc, lds);
#pragma unroll
      for (int f = 0; f < 2; ++f)
#pragma unroll
        for (int t = 0; t < 2; ++t)
#pragma unroll
          for (int j = 0; j < 8; ++j) {
            const unsigned u = gp[f][t][j];
            accM[f][t][2 * j] += __uint_as_float(u << 16) * acc[f][t][2 * j];
            accM[f][t][2 * j + 1] += __uint_as_float(u & 0xffff0000u) * acc[f][t][2 * j + 1];
          }
    }
#pragma unroll
    for (int f = 0; f < 2; ++f)
#pragma unroll
      for (int t = 0; t < 2; ++t) {
        const int token = tt * 256 + (wt * 2 + t) * 32 + r;
#pragma unroll
        for (int g4 = 0; g4 < 4; ++g4) {
          u32x2 w; w[0] = pk2(accM[f][t][4 * g4], accM[f][t][4 * g4 + 1]); w[1] = pk2(accM[f][t][4 * g4 + 2], accM[f][t][4 * g4 + 3]);
          *(u32x2*)(merged + (size_t)token * D + f0 + (wf * 2 + f) * 32 + 8 * g4 + 4 * hh) = w;
        }
      }
  }
}

template <int VAR, int DV>
DI void attn_core(const P& p, int b, int q0, int qoff, int koff, int vf0, int hfox, char* lds, f32x16 (&O)[DV / 32], float& lsum) {
  const int tid = TID(), lane = tid & 63, wave = tid >> 6, r = lane & 31, hh = lane >> 5;
  char* Kt = lds; char* Vt = lds + 64 * ROWB; float* cumt = (float*)(lds + 64 * ROWB + DV * ROWB);
  const int qw = q0 + wave * 32, query = qw + r;
  constexpr float SC2 = 0.125f * LOG2E;
  bf16x8 qf[4];
  {
    const u16* qp = p.PR + (size_t)(b * S + query) * NPR + qoff;
#pragma unroll
    for (int ks = 0; ks < 4; ++ks) qf[ks] = *(const bf16x8*)(qp + ks * 16 + hh * 8);
  }
#pragma unroll
  for (int db = 0; db < DV / 32; ++db) O[db] = zero16();
  float m = -INFINITY, l = 0.f, R = (VAR == 2) ? 1.f : 0.f, cq = 0.f;
  if (VAR == 1) cq = p.CUM[(size_t)(b * 4 + hfox) * S + query];
  const float cq2 = cq * LOG2E;
  const int nkt = q0 / 64 + 4;
  u32x4 rk[1], rv[DV / 64]; float rc = 0.f; u32x2 rm = {0u, 0u};
  auto prefetch = [&](int kt) {
    const int kb = kt * 64;
    {
      const int row = tid >> 3, kc = tid & 7;
      rk[0] = *(const u32x4*)(p.PR + (size_t)(b * S + kb + row) * NPR + koff + kc * 8);
    }
#pragma unroll
    for (int i = 0; i < DV / 64; ++i) {
      const int c = tid + 512 * i, row = c >> 3, kc = c & 7;
      rv[i] = *(const u32x4*)(p.VT + ((size_t)(b * NV + vf0 + row)) * S + kb + kc * 8);
    }
    if (VAR == 1) { if (tid < 64) rc = p.CUM[(size_t)(b * 4 + hfox) * S + kb + tid]; }
    if (VAR == 3) rm = *(const u32x2*)(p.MASK + (size_t)(b * S + query) * 128 + kt * 2);
  };
  prefetch((VAR == 2) ? (nkt - 1) : 0);
  for (int it = 0; it < nkt; ++it) {
    const int kt = (VAR == 2) ? (nkt - 1 - it) : it;
    const int kb = kt * 64;
    __syncthreads();
    {
      const int row = tid >> 3, kc = tid & 7;
      *(u32x4*)(Kt + row * ROWB + kc * 16) = rk[0];
    }
#pragma unroll
    for (int i = 0; i < DV / 64; ++i) {
      const int c = tid + 512 * i, row = c >> 3, kc = c & 7;
      *(u32x4*)(Vt + row * ROWB + kc * 16) = rv[i];
    }
    if (VAR == 1) { if (tid < 64) cumt[tid] = rc * LOG2E; }
    const u32x2 mw = rm;
    __syncthreads();
    if (it + 1 < nkt) prefetch((VAR == 2) ? (kt - 1) : (kt + 1));
#pragma unroll
    for (int ss = 0; ss < 2; ++ss) {
      const int sub = (VAR == 2) ? 1 - ss : ss;
      const int kb2 = kb + sub * 32;
      if (kb2 > qw + 31) continue;
      f32x16 sacc = zero16();
#pragma unroll
      for (int ks = 0; ks < 4; ++ks) {
        bf16x8 a = *(const bf16x8*)(Kt + (sub * 32 + r) * ROWB + ks * 32 + hh * 16);
        sacc = mfma(a, qf[ks], sacc);
      }
      float pv[16];
      if (VAR != 2) {
        const unsigned w = sub ? mw[1] : mw[0];
        const f32x16 sc = sacc;
#pragma unroll
        for (int i = 0; i < 16; ++i) {
          float sv = sc[i];
          if (VAR == 1) sv += cq2 - cumt[sub * 32 + crow(i, hh)];
          pv[i] = sv;
        }
        if (VAR == 3) {
#pragma unroll
          for (int i = 0; i < 16; ++i) pv[i] = (((w >> crow(i, hh)) & 1u) != 0u) ? pv[i] : -INFINITY;
        } else if (kb2 + 31 > qw) {
#pragma unroll
          for (int i = 0; i < 16; ++i) pv[i] = (kb2 + crow(i, hh) <= query) ? pv[i] : -INFINITY;
        }
        float mx = pv[0];
#pragma unroll
        for (int i = 1; i < 16; ++i) mx = fmaxf(mx, pv[i]);
        mx = xmax32(mx);
        const float mn = fmaxf(m, mx);
        const float mu = (mn == -INFINITY) ? 0.f : mn;
        if (__any(mn != m)) {
          const float alpha = __builtin_amdgcn_exp2f(m - mu);
          l *= alpha;
#pragma unroll
          for (int db = 0; db < DV / 32; ++db) O[db] = O[db] * alpha;
          m = mn;
        }
        float ps = 0.f;
#pragma unroll
        for (int i = 0; i < 16; ++i) { pv[i] = __builtin_amdgcn_exp2f(pv[i] - mu); ps += pv[i]; }
        l += xsum32(ps);
      } else {
        float bt[16], om[16];
#pragma unroll
        for (int i = 0; i < 16; ++i) {
          const float zc = fmaxf(sacc[i], -115.f);
          const float e = __builtin_amdgcn_exp2f(-zc);
          const float bb = __builtin_amdgcn_rcpf(1.f + e);
          bt[i] = bb;
          om[i] = e * bb;
        }
        if (kb2 + 31 >= qw) {
#pragma unroll
          for (int i = 0; i < 16; ++i) {
            const bool strict = (kb2 + crow(i, hh)) < query;
            bt[i] = strict ? bt[i] : 0.f;
            om[i] = strict ? om[i] : 1.f;
          }
        }
        float go[4], gx[4];
#pragma unroll
        for (int mm = 0; mm < 4; ++mm) go[mm] = (om[4 * mm] * om[4 * mm + 1]) * (om[4 * mm + 2] * om[4 * mm + 3]);
#pragma unroll
        for (int mm = 0; mm < 4; ++mm) gx[mm] = xoth32(go[mm], hh);
        float tail = 1.f;
#pragma unroll
        for (int mm = 3; mm >= 0; --mm) {
          const float later = tail * (hh == 0 ? gx[mm] : 1.f);
          const float a3 = R * later;
          const float a2 = a3 * om[4 * mm + 3];
          const float a1 = a2 * om[4 * mm + 2];
          const float a0 = a1 * om[4 * mm + 1];
          pv[4 * mm + 3] = bt[4 * mm + 3] * a3;
          pv[4 * mm + 2] = bt[4 * mm + 2] * a2;
          pv[4 * mm + 1] = bt[4 * mm + 1] * a1;
          pv[4 * mm + 0] = bt[4 * mm + 0] * a0;
          tail *= go[mm] * gx[mm];
        }
        R *= tail;
      }
      bf16x8 pf[2];
#pragma unroll
      for (int s2 = 0; s2 < 2; ++s2) {
        u32x4 u;
#pragma unroll
        for (int j = 0; j < 4; ++j) u[j] = pk2(pv[8 * s2 + 2 * j], pv[8 * s2 + 2 * j + 1]);
        pf[s2] = __builtin_bit_cast(bf16x8, u);
      }
#pragma unroll
      for (int db = 0; db < DV / 32; ++db)
#pragma unroll
        for (int s2 = 0; s2 < 2; ++s2) {
          const char* vp = Vt + (db * 32 + r) * ROWB + (sub * 32 + 16 * s2 + 4 * hh) * 2;
          u32x2 lo = *(const u32x2*)vp, hi = *(const u32x2*)(vp + 16);
          u32x4 u; u[0] = lo[0]; u[1] = lo[1]; u[2] = hi[0]; u[3] = hi[1];
          O[db] = mfma(__builtin_bit_cast(bf16x8, u), pf[s2], O[db]);
        }
    }
  }
  lsum = l;
}

template <int DV>
DI void store_y(const P& p, int b, int q0, int ycol, const f32x16 (&O)[DV / 32]) {
  const int lane = TID() & 63, wave = TID() >> 6, r = lane & 31, hh = lane >> 5;
  const int token = b * S + q0 + wave * 32 + r;
#pragma unroll
  for (int db = 0; db < DV / 32; ++db)
#pragma unroll
    for (int g4 = 0; g4 < 4; ++g4) {
      u32x2 w; w[0] = pk2(O[db][4 * g4], O[db][4 * g4 + 1]); w[1] = pk2(O[db][4 * g4 + 2], O[db][4 * g4 + 3]);
      *(u32x2*)(p.Y + (size_t)token * NY + ycol + db * 32 + 8 * g4 + 4 * hh) = w;
    }
}

DI void attn_task_diff(const P& p, int l, int b, int h, int q0, char* lds) {
  const int lane = TID() & 63, hh = lane >> 5;
  const float* lq1 = p.in[8] + l * 64; const float* lk1 = p.in[9] + l * 64;
  const float* lq2 = p.in[10] + l * 64; const float* lk2 = p.in[11] + l * 64;
  float d1 = 0.f, d2 = 0.f;
  for (int i = 0; i < 64; ++i) { d1 += lq1[i] * lk1[i]; d2 += lq2[i] * lk2[i]; }
  const float lam_init = 0.8f - 0.6f * expf(-0.3f * (float)l);
  const float lam = expf(d1) - expf(d2) + lam_init;
  f32x16 O1[4], O2[4]; float l1, l2;
  attn_core<0, 128>(p, b, q0, AQ + h * 128, AK + h * 128, h * 128, 0, lds, O1, l1);
  const float i1 = 1.f / l1;
#pragma unroll
  for (int db = 0; db < 4; ++db)
#pragma unroll
    for (int i = 0; i < 16; ++i) O1[db][i] *= i1;
  attn_core<0, 128>(p, b, q0, AQ + h * 128 + 64, AK + h * 128 + 64, h * 128, 0, lds, O2, l2);
  const float i2 = lam / l2;
  float ss = 0.f;
#pragma unroll
  for (int db = 0; db < 4; ++db)
#pragma unroll
    for (int i = 0; i < 16; ++i) { const float v = O1[db][i] - i2 * O2[db][i]; O1[db][i] = v; ss += v * v; }
  ss = xsum32(ss);
  const float rs = rsqrtf(ss * (1.f / 128.f) + 1e-5f) * (1.f - lam_init);
  const float* dg = p.in[12] + l * 128;
#pragma unroll
  for (int db = 0; db < 4; ++db)
#pragma unroll
    for (int i = 0; i < 16; ++i) O1[db][i] *= rs * dg[db * 32 + crow(i, hh)];
  store_y<128>(p, b, q0, h * 128, O1);
}
template <int VAR>
DI void attn_task_64(const P& p, int b, int h, int q0, char* lds) {
  f32x16 O[2]; float ls;
  constexpr int qo = (VAR == 1) ? BQ : (VAR == 2 ? CQ : DQ);
  constexpr int ko = (VAR == 1) ? BKo : (VAR == 2 ? CK : DK);
  constexpr int vo = (VAR == 1) ? 512 : (VAR == 2 ? 768 : 1024);
  attn_core<VAR, 64>(p, b, q0, qo + h * 64, ko + h * 64, vo + h * 64, h, lds, O, ls);
  if (VAR != 2) {
    const float il = 1.f / ls;
#pragma unroll
    for (int db = 0; db < 2; ++db)
#pragma unroll
      for (int i = 0; i < 16; ++i) O[db][i] *= il;
  }
  store_y<64>(p, b, q0, vo + h * 64, O);
}

DI void idx_task(const P& p, int b, int t0, char* lds) {
  float* sc = (float*)lds;
  const int tid = TID(), lane = tid & 63, wave = tid >> 6, r = lane & 31, hh = lane >> 5;
  __syncthreads();
  bf16x8 afA[4], afB[4];
  {
    const u16* ap = p.PR + (size_t)(b * S + t0 + (r >> 3)) * NPR + IQ + (r & 7) * 64;
#pragma unroll
    for (int ks = 0; ks < 4; ++ks) { afA[ks] = *(const bf16x8*)(ap + ks * 16 + hh * 8); afB[ks] = *(const bf16x8*)(ap + (size_t)4 * NPR + ks * 16 + hh * 8); }
  }
  float iwA[16], iwB[16];
#pragma unroll
  for (int i = 0; i < 16; ++i) {
    iwA[i] = p.IW[(size_t)(b * S + t0 + (i >> 2)) * 8 + (i & 3) + 4 * hh];
    iwB[i] = p.IW[(size_t)(b * S + t0 + 4 + (i >> 2)) * 8 + (i & 3) + 4 * hh];
  }
  const int ntile = (t0 + 7) / 32 + 1;
  for (int tb = wave * 4; tb < ntile; tb += 32) {
    bf16x8 bb[4][4];
#pragma unroll
    for (int u = 0; u < 4; ++u) {
      const int tile = min(tb + u, ntile - 1);
      const u16* bp = p.PR + (size_t)(b * S + tile * 32 + r) * NPR + IK;
#pragma unroll
      for (int ks = 0; ks < 4; ++ks) bb[u][ks] = *(const bf16x8*)(bp + ks * 16 + hh * 8);
    }
#pragma unroll
    for (int u = 0; u < 4; ++u) {
      const int tile = tb + u;
      f32x16 accA = zero16(), accB = zero16();
#pragma unroll
      for (int ks = 0; ks < 4; ++ks) { accA = mfma(afA[ks], bb[u][ks], accA); accB = mfma(afB[ks], bb[u][ks], accB); }
      float sA[4], sB[4];
#pragma unroll
      for (int q = 0; q < 4; ++q) {
        float va = 0.f, vb = 0.f;
#pragma unroll
        for (int j = 0; j < 4; ++j) { va += fmaxf(accA[4 * q + j], 0.f) * iwA[4 * q + j]; vb += fmaxf(accB[4 * q + j], 0.f) * iwB[4 * q + j]; }
        sA[q] = xsum32(va); sB[q] = xsum32(vb);
      }
      if (tile < ntile) {
        sc[(2 * hh) * 4096 + tile * 32 + r] = hh ? sA[2] : sA[0];
        sc[(2 * hh + 1) * 4096 + tile * 32 + r] = hh ? sA[3] : sA[1];
        sc[(4 + 2 * hh) * 4096 + tile * 32 + r] = hh ? sB[2] : sB[0];
        sc[(5 + 2 * hh) * 4096 + tile * 32 + r] = hh ? sB[3] : sB[1];
      }
    }
  }
  __syncthreads();
  const int t = __builtin_amdgcn_readfirstlane(t0 + wave);
  unsigned key[64];
#pragma unroll
  for (int c = 0; c < 64; ++c) {
    const int s = c * 64 + lane;
    unsigned u = __float_as_uint(sc[wave * 4096 + s]);
    u = (u & 0x80000000u) ? ~u : (u | 0x80000000u);
    key[c] = (s <= t) ? u : 0u;
  }
  u64 mymask = 0;
  const int nch = (t >> 6) + 1;
  if (t >= 256) {
    unsigned T = 0;
    bool exact = false;
    for (int bit = 31; bit >= 0; --bit) {
      const unsigned cand = T | (1u << bit);
      int cl = 0;
#pragma unroll
      for (int g = 0; g < 8; ++g) {
        if (g * 8 < nch) {
#pragma unroll
          for (int c = g * 8; c < g * 8 + 8; ++c) cl += (key[c] >= cand) ? 1 : 0;
        }
      }
      const int cnt = wave_sum_i32(cl);
      if (cnt >= 256) T = cand;
      if (cnt == 256) { exact = true; break; }
    }
    if (exact) {
#pragma unroll
      for (int c = 0; c < 64; ++c) {
        const u64 mk = __ballot(key[c] >= T);
        if (lane == c) mymask = mk;
      }
    } else {
    int ngt = 0;
#pragma unroll
    for (int c = 0; c < 64; ++c) ngt += __popcll(__ballot(key[c] > T));
    int rem = 256 - ngt;
#pragma unroll
    for (int c = 0; c < 64; ++c) {
      const u64 gt = __ballot(key[c] > T);
      u64 eq = __ballot(key[c] == T);
      int e = __popcll(eq);
      while (e > rem) { eq &= ~(1ull << (63 - __clzll(eq))); --e; }
      rem -= e;
      const u64 mk = gt | eq;
      if (lane == c) mymask = mk;
    }
    }
  } else {
#pragma unroll
    for (int c = 0; c < 64; ++c) {
      const u64 mk = __ballot(c * 64 + lane <= t);
      if (lane == c) mymask = mk;
    }
  }
  *(u64*)(p.MASK + (size_t)(b * S + t) * 128 + lane * 2) = mymask;
}

DI void scan_task(const P& p, int pair) {
  const int lane = TID() & 63;
  const int b = pair >> 2, h = pair & 3;
  const float* src = p.FL + ((size_t)(b * S + lane * 64)) * 4 + h;
  float v[64];
#pragma unroll
  for (int j = 0; j < 64; ++j) v[j] = src[j * 4];
#pragma unroll
  for (int j = 1; j < 64; ++j) v[j] += v[j - 1];
  float tot = v[63], inc = tot;
#pragma unroll
  for (int o = 1; o < 64; o <<= 1) { const float u = __shfl_up(inc, o); if (lane >= o) inc += u; }
  const float off = inc - tot;
  float* dst = p.CUM + (size_t)pair * S + lane * 64;
#pragma unroll
  for (int j = 0; j < 64; j += 4) {
    f32x4 o4; o4[0] = v[j] + off; o4[1] = v[j + 1] + off; o4[2] = v[j + 2] + off; o4[3] = v[j + 3] + off;
    *(f32x4*)(dst + j) = o4;
  }
}

DI int zz_id(int r) { const int G = gridDim.x, bb = blockIdx.x; return r * G + ((r & 1) ? (G - 1 - bb) : bb); }
DI bool attn_map(int r, int& bh, int& qt) {
  if (gridDim.x == 256) {
    if (r >= 2) return false;
    const int x = blockIdx.x & 7, jb = blockIdx.x >> 3;
    bh = 4 * x + (jb >> 3);
    qt = (r == 0) ? 15 - (jb & 7) : (jb & 7);
    return true;
  }
  if (r * (int)gridDim.x >= 512) return false;
  const int id = zz_id(r);
  if (id >= 512) { bh = -1; return true; }
  bh = id & 31; qt = 15 - (id >> 5);
  return true;
}
DI void phase_mix1(const P& p, int l, char* lds) {
  for (int task = blockIdx.x; task < 4; task += gridDim.x) scan_task(p, task * 8 + (TID() >> 6));
  for (int r = 0; r * (int)gridDim.x < 4096; ++r) {
    const int id = zz_id(r); if (id >= 4096) continue;
    const int trev = id >> 3, b = id & 7;
    idx_task(p, b, (511 - trev) * 8, lds);
  }
  int bh, qt;
  for (int r = 0; attn_map(r, bh, qt); ++r) { if (bh >= 0) attn_task_diff(p, l, bh >> 2, bh & 3, qt * 256, lds); }
  for (int r = 0; attn_map(r, bh, qt); ++r) { if (bh >= 0) attn_task_64<2>(p, bh >> 2, bh & 3, qt * 256, lds); }
}
DI void phase_mix2(const P& p, char* lds) {
  int bh, qt;
  for (int r = 0; attn_map(r, bh, qt); ++r) { if (bh >= 0) attn_task_64<1>(p, bh >> 2, bh & 3, qt * 256, lds); }
  for (int r = 0; attn_map(r, bh, qt); ++r) { if (bh >= 0) attn_task_64<3>(p, bh >> 2, bh & 3, qt * 256, lds); }
}

__global__ void __launch_bounds__(512, 2) mega_kernel(P p) {
  __shared__ __attribute__((aligned(16))) char lds[LDS_BYTES];
  cg::grid_group grid = cg::this_grid();
  u16* act = p.PR; u16* merged = p.PR;
  for (int l = 0; l < 2; ++l) {
    const float* xcur = (l == 0) ? p.in[0] : p.xres;
    phase_conv(p, l, lds); phase_norm(xcur, p.in[2] + l * D, p.hb); grid.sync();
    phase_gu(p, p.Wt + OFF_GU1, act, lds); grid.sync();
    phase_resid(p.Wt + OFF_DN1, act, DFF, xcur, p.xres, 0.5f, lds); grid.sync();
    phase_norm(p.xres, p.in[5] + l * D, p.hb); grid.sync();
    phase_proj(p, l, lds); grid.sync();
    phase_mix1(p, l, lds); grid.sync();
    phase_mix2(p, lds); grid.sync();
    phase_merge(p, l, merged, lds); grid.sync();
    phase_resid(p.Wt + OFF_OUT, merged, D, p.xres, p.xres, 1.0f, lds); grid.sync();
    phase_norm(p.xres, p.in[20] + l * D, p.hb); grid.sync();
    phase_gu(p, p.Wt + OFF_GU2, act, lds); grid.sync();
    phase_resid(p.Wt + OFF_DN2, act, DFF, p.xres, p.xres, 0.5f, lds); grid.sync();
  }
  phase_final_norm(p.xres, p.in[23]);
}

extern "C" void kernel_launch(void* const* d_in, const int* in_sizes, int n_in, void* d_out, int out_size, void* d_ws, size_t ws_size, hipStream_t stream) {
  P p{};
  for (int i = 0; i < 24; ++i) p.in[i] = (const float*)d_in[i];
  p.pos = (const int*)d_in[1];
  p.xres = (float*)d_out;
  char* w = (char*)d_ws; size_t off = 0;
  auto take = [&](size_t bytes) { char* r = w + off; off += (bytes + 255) & ~(size_t)255; return r; };
  p.Wt = (u16*)take(WT_ELEMS * 2);
  p.hb = (u16*)take((size_t)M * D * 2);
  p.PR = (u16*)take((size_t)M * NPR * 2);
  p.VT = (u16*)take((size_t)NB * NV * S * 2);
  p.Y = (u16*)take((size_t)M * NY * 2);
  p.MASK = (unsigned*)take((size_t)M * 128 * 4);
  p.FL = (float*)take((size_t)M * 4 * 4);
  p.IW = (float*)take((size_t)M * 8 * 4);
  p.CUM = (float*)take((size_t)M * 4 * 4);
  p.COS = (float*)take((size_t)S * 8 * 4);
  p.SIN = (float*)take((size_t)S * 8 * 4);
  if (off > ws_size) { fprintf(stderr, "workspace too small: need %zu have %zu\n", off, ws_size); return; }
  static int grid_blocks = 0;
  if (!grid_blocks) {
    int dev = 0, cus = 0, per_cu = 0;
    hipGetDevice(&dev);
    hipDeviceGetAttribute(&cus, hipDeviceAttributeMultiprocessorCount, dev);
    hipOccupancyMaxActiveBlocksPerMultiprocessor(&per_cu, mega_kernel, 512, 0);
    grid_blocks = cus * (per_cu < 1 ? 1 : per_cu);
  }
  void* args[] = {&p};
  hipError_t e = hipLaunchCooperativeKernel((void*)mega_kernel, dim3(grid_blocks), dim3(512), args, 0, stream);
  if (e != hipSuccess) fprintf(stderr, "cooperative launch failed: %s (grid %d)\n", hipGetErrorString(e), grid_blocks);
}
```

```cpp
#include <hip/hip_runtime.h>
#include <hip/hip_cooperative_groups.h>
#include <cstdio>
namespace cg = cooperative_groups;

#define DI __device__ __forceinline__
typedef unsigned short u16;
typedef unsigned long long u64;
typedef __attribute__((ext_vector_type(8))) short bf16x8;
typedef __attribute__((ext_vector_type(16))) float f32x16;
typedef __attribute__((ext_vector_type(4))) float f32x4;
typedef __attribute__((ext_vector_type(2))) float f32x2;
typedef __attribute__((ext_vector_type(2))) __bf16 bf2;
typedef __attribute__((ext_vector_type(4))) unsigned u32x4;
typedef __attribute__((ext_vector_type(2))) unsigned u32x2;

constexpr int D = 1024, NB = 8, S = 4096, M = NB * S, DFF = 2816;
constexpr int NPR = 3200, NV = 1280, NY = 1280;
constexpr int AQ = 0, AK = 512, BQ = 1024, BKo = 1280, CQ = 1536, CK = 1792, DQ = 2048, DK = 2304, IQ = 2560, IK = 3072, SMALL = 3136;
constexpr size_t OFF_GU1 = 0;
constexpr size_t OFF_DN1 = OFF_GU1 + (size_t)5632 * 1024;
constexpr size_t OFF_IN = OFF_DN1 + (size_t)1024 * 2816;
constexpr size_t OFF_GATE = OFF_IN + (size_t)4608 * 1024;
constexpr size_t OFF_BRA = OFF_GATE + (size_t)4096 * 1024;
constexpr size_t OFF_BRB = OFF_BRA + (size_t)1024 * 512;
constexpr size_t OFF_BRC = OFF_BRB + (size_t)1024 * 256;
constexpr size_t OFF_BRD = OFF_BRC + (size_t)1024 * 256;
constexpr size_t OFF_OUT = OFF_BRD + (size_t)1024 * 256;
constexpr size_t OFF_GU2 = OFF_OUT + (size_t)1024 * 1024;
constexpr size_t OFF_DN2 = OFF_GU2 + (size_t)5632 * 1024;
constexpr size_t WT_ELEMS = OFF_DN2 + (size_t)1024 * 2816;

constexpr float LOG2E = 1.4426950408889634f;
constexpr int LDS_BYTES = 131072;
constexpr int ROWB = 144;

struct P {
  const float* in[24];
  const int* pos;
  float* xres;
  u16* Wt; u16* hb; u16* PR; u16* VT; u16* Y;
  unsigned* MASK; float* FL; float* IW; float* CUM; float* COS; float* SIN;
};

DI int TID() { int t = (int)__builtin_amdgcn_workitem_id_x(); asm volatile("" : "+v"(t)); return t; }
DI unsigned pk2(float a, float b) { f32x2 v = {a, b}; bf2 r = __builtin_convertvector(v, bf2); return __builtin_bit_cast(unsigned, r); }
DI u16 f2bf(float a) { __bf16 h = (__bf16)a; return __builtin_bit_cast(u16, h); }
DI float wsum(float v) {
#pragma unroll
  for (int o = 32; o > 0; o >>= 1) v += __shfl_xor(v, o);
  return v;
}
DI float xmax32(float x) { auto r2 = __builtin_amdgcn_permlane32_swap(__float_as_uint(x), __float_as_uint(x), false, false); return fmaxf(__uint_as_float(r2[0]), __uint_as_float(r2[1])); }
DI float xsum32(float x) { auto r2 = __builtin_amdgcn_permlane32_swap(__float_as_uint(x), __float_as_uint(x), false, false); return __uint_as_float(r2[0]) + __uint_as_float(r2[1]); }
DI float xoth32(float x, int hh) { auto r2 = __builtin_amdgcn_permlane32_swap(__float_as_uint(x), __float_as_uint(x), false, false); return __uint_as_float(hh ? r2[0] : r2[1]); }
DI int wave_sum_i32(int v) {
  v += __builtin_amdgcn_update_dpp(0, v, 0xB1, 0xf, 0xf, false);
  v += __builtin_amdgcn_update_dpp(0, v, 0x4E, 0xf, 0xf, false);
  v += __builtin_amdgcn_update_dpp(0, v, 0x141, 0xf, 0xf, false);
  v += __builtin_amdgcn_update_dpp(0, v, 0x140, 0xf, 0xf, false);
  v += __builtin_amdgcn_update_dpp(0, v, 0x142, 0xa, 0xf, false);
  v += __builtin_amdgcn_update_dpp(0, v, 0x143, 0xc, 0xf, false);
  return __builtin_amdgcn_readlane(v, 63);
}
DI constexpr int crow(int i, int hh) { return (i & 3) + 8 * (i >> 2) + 4 * hh; }
DI f32x16 mfma(bf16x8 a, bf16x8 b, f32x16 c) { return __builtin_amdgcn_mfma_f32_32x32x16_bf16(a, b, c, 0, 0, 0); }
DI f32x16 zero16() { f32x16 z;
#pragma unroll
  for (int i = 0; i < 16; ++i) z[i] = 0.f; return z; }

DI void phase_norm(const float* __restrict__ src, const float* __restrict__ g, u16* __restrict__ dst) {
  const int lane = TID() & 63;
  const int wave = (blockIdx.x * 512 + TID()) >> 6, nw = gridDim.x * 8;
  for (int row = wave; row < M; row += nw) {
    const f32x4* p = (const f32x4*)(src + (size_t)row * D);
    f32x4 v[4]; float ss = 0.f;
#pragma unroll
    for (int j = 0; j < 4; ++j) { v[j] = __builtin_nontemporal_load(p + lane + 64 * j); ss += v[j][0] * v[j][0] + v[j][1] * v[j][1] + v[j][2] * v[j][2] + v[j][3] * v[j][3]; }
    ss = wsum(ss);
    const float rs = rsqrtf(ss * (1.f / D) + 1e-6f);
#pragma unroll
    for (int j = 0; j < 4; ++j) {
      f32x4 gg = ((const f32x4*)g)[lane + 64 * j];
      u32x2 o; o[0] = pk2(v[j][0] * rs * gg[0], v[j][1] * rs * gg[1]); o[1] = pk2(v[j][2] * rs * gg[2], v[j][3] * rs * gg[3]);
      *(u32x2*)(dst + (size_t)row * D + (lane + 64 * j) * 4) = o;
    }
  }
}
DI void phase_final_norm(float* __restrict__ x, const float* __restrict__ g) {
  const int lane = TID() & 63;
  const int wave = (blockIdx.x * 512 + TID()) >> 6, nw = gridDim.x * 8;
  for (int row = wave; row < M; row += nw) {
    f32x4* p = (f32x4*)(x + (size_t)row * D);
    f32x4 v[4]; float ss = 0.f;
#pragma unroll
    for (int j = 0; j < 4; ++j) { v[j] = p[lane + 64 * j]; ss += v[j][0] * v[j][0] + v[j][1] * v[j][1] + v[j][2] * v[j][2] + v[j][3] * v[j][3]; }
    ss = wsum(ss);
    const float rs = rsqrtf(ss * (1.f / D) + 1e-6f);
#pragma unroll
    for (int j = 0; j < 4; ++j) {
      f32x4 gg = ((const f32x4*)g)[lane + 64 * j];
      f32x4 o; o[0] = v[j][0] * rs * gg[0]; o[1] = v[j][1] * rs * gg[1]; o[2] = v[j][2] * rs * gg[2]; o[3] = v[j][3] * rs * gg[3];
      p[lane + 64 * j] = o;
    }
  }
}

DI int map_gu(int n) { int c = (n < DFF) ? n : n - DFF; return (c >> 5) * 64 + (c & 31) + ((n < DFF) ? 0 : 32); }
DI int map_in(int n) {
  if (n < 512) return n;
  if (n < 1024) return n;
  if (n < 1536) return n - 1024 + 3200;
  if (n < 1792) return n - 1536 + BQ;
  if (n < 2048) return n - 1792 + BKo;
  if (n < 2304) return n - 2048 + 3200 + 512;
  if (n < 2308) return n - 2304 + SMALL;
  if (n < 2564) return n - 2308 + CQ;
  if (n < 2820) return n - 2564 + CK;
  if (n < 3076) return n - 2820 + 3200 + 768;
  if (n < 3332) return n - 3076 + DQ;
  if (n < 3588) return n - 3332 + DK;
  if (n < 3844) return n - 3588 + 3200 + 1024;
  if (n < 4356) return n - 3844 + IQ;
  if (n < 4420) return n - 4356 + IK;
  return n - 4420 + SMALL + 4;
}
DI void conv_w(const float* __restrict__ W, int K, int N, u16* __restrict__ Wt, int mp, char* lds) {
  const int tid = TID(), half = tid >> 8, t8 = tid & 255, tn = t8 & 15, tk = t8 >> 4;
  char* my = lds + half * (64 * ROWB);
  const int ntn = (N + 63) >> 6, ntk = K >> 6, ntile = ntn * ntk;
  for (int base = 2 * blockIdx.x; base < ntile; base += 2 * gridDim.x) {
    const int tile = base + half;
    const bool on = tile < ntile;
    const int n0 = (tile % ntn) * 64, k0 = (tile / ntn) * 64;
    f32x4 v[4];
    const int n = n0 + 4 * tn;
#pragma unroll
    for (int i = 0; i < 4; ++i) {
      if (on && n < N) v[i] = __builtin_nontemporal_load((const f32x4*)(W + (size_t)(k0 + 4 * tk + i) * N + n));
      else { v[i][0] = 0.f; v[i][1] = 0.f; v[i][2] = 0.f; v[i][3] = 0.f; }
    }
    __syncthreads();
#pragma unroll
    for (int j = 0; j < 4; ++j) {
      u32x2 w; w[0] = pk2(v[0][j], v[1][j]); w[1] = pk2(v[2][j], v[3][j]);
      *(u32x2*)(my + (4 * tn + j) * ROWB + tk * 8) = w;
    }
    __syncthreads();
#pragma unroll
    for (int ps = 0; ps < 2; ++ps) {
      const int nn = (t8 >> 3) + 32 * ps, c = t8 & 7, ng = n0 + nn;
      if (on && ng < N) {
        const int np = (mp == 0) ? ng : (mp == 1 ? map_gu(ng) : map_in(ng));
        *(u32x4*)(Wt + (size_t)np * K + k0 + 8 * c) = *(const u32x4*)(my + nn * ROWB + c * 16);
      }
    }
  }
}
DI void phase_conv(const P& p, int l, char* lds) {
  conv_w(p.in[3] + (size_t)l * 1024 * 5632, 1024, 5632, p.Wt + OFF_GU1, 1, lds);
  conv_w(p.in[4] + (size_t)l * 2816 * 1024, 2816, 1024, p.Wt + OFF_DN1, 0, lds);
  conv_w(p.in[6] + (size_t)l * 1024 * 4428, 1024, 4428, p.Wt + OFF_IN, 2, lds);
  conv_w(p.in[13] + (size_t)l * 1024 * 4096, 1024, 4096, p.Wt + OFF_GATE, 0, lds);
  conv_w(p.in[15] + (size_t)l * 512 * 1024, 512, 1024, p.Wt + OFF_BRA, 0, lds);
  conv_w(p.in[16] + (size_t)l * 256 * 1024, 256, 1024, p.Wt + OFF_BRB, 0, lds);
  conv_w(p.in[17] + (size_t)l * 256 * 1024, 256, 1024, p.Wt + OFF_BRC, 0, lds);
  conv_w(p.in[18] + (size_t)l * 256 * 1024, 256, 1024, p.Wt + OFF_BRD, 0, lds);
  conv_w(p.in[19] + (size_t)l * 1024 * 1024, 1024, 1024, p.Wt + OFF_OUT, 0, lds);
  conv_w(p.in[21] + (size_t)l * 1024 * 5632, 1024, 5632, p.Wt + OFF_GU2, 1, lds);
  conv_w(p.in[22] + (size_t)l * 2816 * 1024, 2816, 1024, p.Wt + OFF_DN2, 0, lds);
  const int gt = blockIdx.x * 512 + TID(), nt = gridDim.x * 512;
  for (int i = gt; i < 52 * 1024; i += nt) p.Wt[OFF_IN + (size_t)3148 * 1024 + i] = 0;
  for (int i = gt; i < 128 * 1024; i += nt) p.Wt[OFF_IN + (size_t)4480 * 1024 + i] = 0;
  if (l == 0) {
    for (int i = gt; i < S * 8; i += nt) {
      const int s = i >> 3, c = i & 7;
      const float freq = powf(500000.0f, -(float)(2 * c) / 16.0f);
      const float ang = (float)p.pos[s] * freq;
      p.COS[i] = cosf(ang); p.SIN[i] = sinf(ang);
    }
  }
}

#define LAS __attribute__((address_space(3)))
template <int WF, int WT, int WGT, int PF = 1>
DI void gemm_loop(const u16* __restrict__ A, size_t lda, const u16* __restrict__ B, size_t ldb, int K, f32x16 (&acc)[WF][WT], char* lds) {
  constexpr int WGF = 8 / WGT;
  constexpr int BF = 32 * WF * WGF, BT = 32 * WT * WGT;
  constexpr int ABYTES = BF * 128, BBYTES = BT * 128, STAGE = ABYTES + BBYTES;
  constexpr int IA = BF / 64, IB = BT / 64;
  static_assert(2 * STAGE <= LDS_BYTES, "lds");
  const int tid = TID(), lane = tid & 63, wave = tid >> 6;
  const int wf = wave / WGT, wt = wave % WGT, r = lane & 31, hh = lane >> 5;
  const int kcs = (tid & 7) ^ ((tid >> 4) & 7);
  const u16* ga = A + (size_t)(tid >> 3) * lda + kcs * 8;
  const u16* gb = B + (size_t)(tid >> 3) * ldb + kcs * 8;
  LAS char* l3 = (LAS char*)lds;
  const int sw = (r >> 1) & 7;
  __syncthreads();
#pragma unroll
  for (int i = 0; i < IA; ++i) __builtin_amdgcn_global_load_lds((const unsigned*)(ga + (size_t)i * 64 * lda), (LAS unsigned*)(l3 + i * 8192 + wave * 1024), 16, 0, 0);
#pragma unroll
  for (int i = 0; i < IB; ++i) __builtin_amdgcn_global_load_lds((const unsigned*)(gb + (size_t)i * 64 * ldb), (LAS unsigned*)(l3 + ABYTES + i * 8192 + wave * 1024), 16, 0, 0);
  const int nk = K >> 6;
  for (int kt = 0; kt < nk; ++kt) {
    __syncthreads();
    if (kt + 1 < nk) {
      const int nb = ((kt + 1) & 1) * STAGE, k0 = (kt + 1) * 64;
#pragma unroll
      for (int i = 0; i < IA; ++i) __builtin_amdgcn_global_load_lds((const unsigned*)(ga + (size_t)i * 64 * lda + k0), (LAS unsigned*)(l3 + nb + i * 8192 + wave * 1024), 16, 0, 0);
#pragma unroll
      for (int i = 0; i < IB; ++i) __builtin_amdgcn_global_load_lds((const unsigned*)(gb + (size_t)i * 64 * ldb + k0), (LAS unsigned*)(l3 + nb + ABYTES + i * 8192 + wave * 1024), 16, 0, 0);
    }
    const char* sa = lds + (kt & 1) * STAGE;
    const char* sb = sa + ABYTES;
    bf16x8 af[PF + 1][WF], bfr[PF + 1][WT];
    if (PF) {
      const int co = ((0 * 2 + hh) ^ sw) << 4;
#pragma unroll
      for (int f = 0; f < WF; ++f) af[0][f] = *(const bf16x8*)(sa + ((wf * WF + f) * 32 + r) * 128 + co);
#pragma unroll
      for (int t = 0; t < WT; ++t) bfr[0][t] = *(const bf16x8*)(sb + ((wt * WT + t) * 32 + r) * 128 + co);
    }
#pragma unroll
    for (int ks = 0; ks < 4; ++ks) {
      const int ld = PF ? ks + 1 : ks, li = PF ? ((ks + 1) & 1) : 0, ci = PF ? (ks & 1) : 0;
      if (ld < 4) {
        const int co = ((ld * 2 + hh) ^ sw) << 4;
#pragma unroll
        for (int f = 0; f < WF; ++f) af[li][f] = *(const bf16x8*)(sa + ((wf * WF + f) * 32 + r) * 128 + co);
#pragma unroll
        for (int t = 0; t < WT; ++t) bfr[li][t] = *(const bf16x8*)(sb + ((wt * WT + t) * 32 + r) * 128 + co);
      }
#pragma unroll
      for (int f = 0; f < WF; ++f)
#pragma unroll
        for (int t = 0; t < WT; ++t) acc[f][t] = mfma(af[ci][f], bfr[ci][t], acc[f][t]);
    }
    __syncthreads();
  }
}
template <int PT = 8>
DI bool tile_at(int round, int NF, int ntiles, int& ft, int& tt) {
  const int G8 = gridDim.x >> 3;
  const int L = (round * 8 + (int)(blockIdx.x & 7)) * G8 + (int)(blockIdx.x >> 3);
  if (L >= ntiles) return false;
  const int tg = L / (NF * PT), rem = L - tg * NF * PT;
  ft = rem / PT; tt = tg * PT + (rem % PT);
  return true;
}

DI void phase_gu(const P& p, const u16* __restrict__ Wt, u16* __restrict__ act, char* lds) {
  const int lane = TID() & 63, wave = TID() >> 6, wf = wave >> 2, wt = wave & 3, r = lane & 31, hh = lane >> 5;
  for (int rnd = 0; rnd * (int)gridDim.x < 22 * 128; ++rnd) {
    int ft, tt; if (!tile_at<4>(rnd, 22, 22 * 128, ft, tt)) continue;
    f32x16 acc[4][2];
#pragma unroll
    for (int f = 0; f < 4; ++f)
#pragma unroll
      for (int t = 0; t < 2; ++t) acc[f][t] = zero16();
    gemm_loop<4, 2, 4>(Wt + (size_t)ft * 256 * 1024, 1024, p.hb + (size_t)tt * 256 * 1024, 1024, 1024, acc, lds);
#pragma unroll
    for (int t = 0; t < 2; ++t) {
      const int token = tt * 256 + (wt * 2 + t) * 32 + r;
#pragma unroll
      for (int pr = 0; pr < 2; ++pr) {
        const int c0 = ft * 128 + wf * 64 + pr * 32;
#pragma unroll
        for (int g4 = 0; g4 < 4; ++g4) {
          float o[4];
#pragma unroll
          for (int j = 0; j < 4; ++j) { const float g = acc[2 * pr][t][4 * g4 + j], u = acc[2 * pr + 1][t][4 * g4 + j]; o[j] = g * __builtin_amdgcn_rcpf(1.f + __builtin_amdgcn_exp2f(-LOG2E * g)) * u; }
          u32x2 w; w[0] = pk2(o[0], o[1]); w[1] = pk2(o[2], o[3]);
          *(u32x2*)(act + (size_t)token * DFF + c0 + 8 * g4 + 4 * hh) = w;
        }
      }
    }
  }
}
DI void phase_resid(const u16* __restrict__ Wt, const u16* __restrict__ B, int K, const float* __restrict__ xsrc, float* __restrict__ xout, float alpha, char* lds) {
  const int lane = TID() & 63, wave = TID() >> 6, wf = wave >> 2, wt = wave & 3, r = lane & 31, hh = lane >> 5;
  for (int rnd = 0; rnd * (int)gridDim.x < 4 * 128; ++rnd) {
    int ft, tt; if (!tile_at(rnd, 4, 4 * 128, ft, tt)) continue;
    f32x16 acc[4][2];
#pragma unroll
    for (int f = 0; f < 4; ++f)
#pragma unroll
      for (int t = 0; t < 2; ++t) acc[f][t] = zero16();
    gemm_loop<4, 2, 4>(Wt + (size_t)ft * 256 * K, K, B + (size_t)tt * 256 * K, K, K, acc, lds);
#pragma unroll
    for (int f = 0; f < 4; ++f)
#pragma unroll
      for (int t = 0; t < 2; ++t) {
        const int token = tt * 256 + (wt * 2 + t) * 32 + r;
        const int fb = ft * 256 + (wf * 4 + f) * 32;
#pragma unroll
        for (int g4 = 0; g4 < 4; ++g4) {
          const size_t off = (size_t)token * D + fb + 8 * g4 + 4 * hh;
          f32x4 xv = *(const f32x4*)(xsrc + off);
#pragma unroll
          for (int j = 0; j < 4; ++j) xv[j] += alpha * acc[f][t][4 * g4 + j];
          *(f32x4*)(xout + off) = xv;
        }
      }
  }
}
DI void phase_proj(const P& p, int l, char* lds) {
  const int lane = TID() & 63, wave = TID() >> 6, wf = wave >> 2, wt = wave & 3, r = lane & 31, hh = lane >> 5;
  const float* bf = p.in[7] + l * 4;
  for (int rnd = 0; rnd * (int)gridDim.x < 18 * 128; ++rnd) {
    int ft, tt; if (!tile_at<4>(rnd, 18, 18 * 128, ft, tt)) continue;
    f32x16 acc[4][2];
#pragma unroll
    for (int f = 0; f < 4; ++f)
#pragma unroll
      for (int t = 0; t < 2; ++t) acc[f][t] = zero16();
    gemm_loop<4, 2, 4>(p.Wt + OFF_IN + (size_t)ft * 256 * 1024, 1024, p.hb + (size_t)tt * 256 * 1024, 1024, 1024, acc, lds);
#pragma unroll
    for (int f = 0; f < 4; ++f)
#pragma unroll
      for (int t = 0; t < 2; ++t) {
        const int token = tt * 256 + (wt * 2 + t) * 32 + r;
        const int fb = ft * 256 + (wf * 4 + f) * 32;
        const int sidx = token & (S - 1), b = token >> 12;
        if (fb < 3200) {
          const bool rope = ((fb & 63) == 0) && (fb < 1024 || (fb >= 2048 && fb < SMALL));
          if (rope) {
            const f32x4 cs = *(const f32x4*)(p.COS + sidx * 8 + 4 * hh);
            const f32x4 sn = *(const f32x4*)(p.SIN + sidx * 8 + 4 * hh);
#pragma unroll
            for (int j = 0; j < 4; ++j) {
              const float x1 = acc[f][t][j], x2 = acc[f][t][4 + j];
              acc[f][t][j] = x1 * cs[j] - x2 * sn[j];
              acc[f][t][4 + j] = x2 * cs[j] + x1 * sn[j];
            }
          }
          const bool isq = (fb < 512) || (fb >= BQ && fb < BKo) || (fb >= CQ && fb < CK) || (fb >= DQ && fb < DK);
          if (isq) acc[f][t] = acc[f][t] * (0.125f * LOG2E);
          if (fb == SMALL) {
            if (hh == 0) {
#pragma unroll
              for (int j = 0; j < 4; ++j) {
                const float z = acc[f][t][j] + bf[j];
                p.FL[(size_t)token * 4 + j] = fminf(z, 0.f) - __logf(1.f + __expf(-fabsf(z)));
                p.IW[(size_t)token * 8 + 4 + j] = acc[f][t][4 + j];
              }
            } else {
#pragma unroll
              for (int j = 0; j < 4; ++j) p.IW[(size_t)token * 8 + j] = acc[f][t][j];
            }
          }
#pragma unroll
          for (int g4 = 0; g4 < 4; ++g4) {
            u32x2 w; w[0] = pk2(acc[f][t][4 * g4], acc[f][t][4 * g4 + 1]); w[1] = pk2(acc[f][t][4 * g4 + 2], acc[f][t][4 * g4 + 3]);
            *(u32x2*)(p.PR + (size_t)token * NPR + fb + 8 * g4 + 4 * hh) = w;
          }
        } else if (fb < 4480) {
          const int vf0 = fb - 3200;
#pragma unroll
          for (int i = 0; i < 16; ++i) p.VT[((size_t)(b * NV + vf0 + crow(i, hh))) * S + sidx] = f2bf(acc[f][t][i]);
        }
      }
  }
}
DI void phase_merge(const P& p, int l, u16* __restrict__ merged, char* lds) {
  const int lane = TID() & 63, wave = TID() >> 6, wf = wave >> 2, wt = wave & 3, r = lane & 31, hh = lane >> 5;
  const float* bg = p.in[14] + (size_t)l * 4096;
  for (int rnd = 0; rnd * (int)gridDim.x < 8 * 128; ++rnd) {
    int ft, tt; if (!tile_at(rnd, 8, 8 * 128, ft, tt)) continue;
    const int f0 = ft * 128;
    f32x16 accM[2][2];
#pragma unroll
    for (int f = 0; f < 2; ++f)
#pragma unroll
      for (int t = 0; t < 2; ++t) accM[f][t] = zero16();
    for (int br = 0; br < 4; ++br) {
      f32x16 acc[2][2];
#pragma unroll
      for (int f = 0; f < 2; ++f)
#pragma unroll
        for (int t = 0; t < 2; ++t) acc[f][t] = zero16();
      gemm_loop<2, 2, 4, 0>(p.Wt + OFF_GATE + (size_t)(br * 1024 + f0) * 1024, 1024, p.hb + (size_t)tt * 256 * 1024, 1024, 1024, acc, lds);
      unsigned gp[2][2][8];
      const int tq = TID(), wfq = tq >> 8, hq = (tq >> 5) & 1;
      const float* bq = bg + br * 1024 + f0 + wfq * 64 + 4 * hq;
#pragma unroll
      for (int f = 0; f < 2; ++f)
#pragma unroll
        for (int j = 0; j < 8; ++j) {
          const float b0 = bq[f * 32 + crow(2 * j, 0)];
          const float b1 = bq[f * 32 + crow(2 * j + 1, 0)];
#pragma unroll
          for (int t = 0; t < 2; ++t) {
            const float g0 = __builtin_amdgcn_rcpf(1.f + __builtin_amdgcn_exp2f(-LOG2E * (acc[f][t][2 * j] + b0)));
            const float g1 = __builtin_amdgcn_rcpf(1.f + __builtin_amdgcn_exp2f(-LOG2E * (acc[f][t][2 * j + 1] + b1)));
            gp[f][t][j] = pk2(g0, g1);
          }
        }
#pragma unroll
      for (int f = 0; f < 2; ++f)
#pragma unroll
        for (int t = 0; t < 2; ++t) acc[f][t] = zero16();
      const int Kb = (br == 0) ? 512 : 256;
      const size_t woff = (br == 0) ? OFF_BRA : OFF_BRB + (size_t)(br - 1) * 1024 * 256;
      const int yoff = (br == 0) ? 0 : 512 + 256 * (br - 1);
      gemm_loop<2, 2, 4, 0>(p.Wt + woff + (size_t)f0 * Kb, Kb, p.Y + (size_t)tt * 256 * NY + yoff, NY, Kb, acc, lds);
#pragma unroll
      for (int f = 0; f < 2; ++f)
#pragma unroll
        for (int t = 0; t < 2; ++t)
#pragma unroll
          for (int j = 0; j < 8; ++j) {
            const unsigned u = gp[f][t][j];
            accM[f][t][2 * j] += __uint_as_float(u << 16) * acc[f][t][2 * j];
            accM[f][t][2 * j + 1] += __uint_as_float(u & 0xffff0000u) * acc[f][t][2 * j + 1];
          }
    }
#pragma unroll
    for (int f = 0; f < 2; ++f)
#pragma unroll
      for (int t = 0; t < 2; ++t) {
        const int token = tt * 256 + (wt * 2 + t) * 32 + r;
#pragma unroll
        for (int g4 = 0; g4 < 4; ++g4) {
          u32x2 w; w[0] = pk2(accM[f][t][4 * g4], accM[f][t][4 * g4 + 1]); w[1] = pk2(accM[f][t][4 * g4 + 2], accM[f][t][4 * g4 + 3]);
          *(u32x2*)(merged + (size_t)token * D + f0 + (wf * 2 + f) * 32 + 8 * g4 + 4 * hh) = w;
        }
      }
  }
}

template <int VAR, int DV>
DI void attn_core(const P& p, int b, int q0, int qoff, int koff, int vf0, int hfox, char* lds, f32x16 (&O)[DV / 32], float& lsum) {
  const int tid = TID(), lane = tid & 63, wave = tid >> 6, r = lane & 31, hh = lane >> 5;
  char* Kt = lds; char* Vt = lds + 64 * ROWB; float* cumt = (float*)(lds + 64 * ROWB + DV * ROWB);
  const int qw = q0 + wave * 32, query = qw + r;
  constexpr float SC2 = 0.125f * LOG2E;
  bf16x8 qf[4];
  {
    const u16* qp = p.PR + (size_t)(b * S + query) * NPR + qoff;
#pragma unroll
    for (int ks = 0; ks < 4; ++ks) qf[ks] = *(const bf16x8*)(qp + ks * 16 + hh * 8);
  }
#pragma unroll
  for (int db = 0; db < DV / 32; ++db) O[db] = zero16();
  float m = -INFINITY, l = 0.f, R = (VAR == 2) ? 1.f : 0.f, cq = 0.f;
  if (VAR == 1) cq = p.CUM[(size_t)(b * 4 + hfox) * S + query];
  const float cq2 = cq * LOG2E;
  const int nkt = q0 / 64 + 4;
  u32x4 rk[1], rv[DV / 64]; float rc = 0.f; u32x2 rm = {0u, 0u};
  auto prefetch = [&](int kt) {
    const int kb = kt * 64;
    {
      const int row = tid >> 3, kc = tid & 7;
      rk[0] = *(const u32x4*)(p.PR + (size_t)(b * S + kb + row) * NPR + koff + kc * 8);
    }
#pragma unroll
    for (int i = 0; i < DV / 64; ++i) {
      const int c = tid + 512 * i, row = c >> 3, kc = c & 7;
      rv[i] = *(const u32x4*)(p.VT + ((size_t)(b * NV + vf0 + row)) * S + kb + kc * 8);
    }
    if (VAR == 1) { if (tid < 64) rc = p.CUM[(size_t)(b * 4 + hfox) * S + kb + tid]; }
    if (VAR == 3) rm = *(const u32x2*)(p.MASK + (size_t)(b * S + query) * 128 + kt * 2);
  };
  prefetch((VAR == 2) ? (nkt - 1) : 0);
  for (int it = 0; it < nkt; ++it) {
    const int kt = (VAR == 2) ? (nkt - 1 - it) : it;
    const int kb = kt * 64;
    __syncthreads();
    {
      const int row = tid >> 3, kc = tid & 7;
      *(u32x4*)(Kt + row * ROWB + kc * 16) = rk[0];
    }
#pragma unroll
    for (int i = 0; i < DV / 64; ++i) {
      const int c = tid + 512 * i, row = c >> 3, kc = c & 7;
      *(u32x4*)(Vt + row * ROWB + kc * 16) = rv[i];
    }
    if (VAR == 1) { if (tid < 64) cumt[tid] = rc * LOG2E; }
    const u32x2 mw = rm;
    __syncthreads();
    if (it + 1 < nkt) prefetch((VAR == 2) ? (kt - 1) : (kt + 1));
#pragma unroll
    for (int ss = 0; ss < 2; ++ss) {
      const int sub = (VAR == 2) ? 1 - ss : ss;
      const int kb2 = kb + sub * 32;
      if (kb2 > qw + 31) continue;
      f32x16 sacc = zero16();
#pragma unroll
      for (int ks = 0; ks < 4; ++ks) {
        bf16x8 a = *(const bf16x8*)(Kt + (sub * 32 + r) * ROWB + ks * 32 + hh * 16);
        sacc = mfma(a, qf[ks], sacc);
      }
      float pv[16];
      if (VAR != 2) {
        const unsigned w = sub ? mw[1] : mw[0];
        const f32x16 sc = sacc;
#pragma unroll
        for (int i = 0; i < 16; ++i) {
          float sv = sc[i];
          if (VAR == 1) sv += cq2 - cumt[sub * 32 + crow(i, hh)];
          pv[i] = sv;
        }
        if (VAR == 3) {
#pragma unroll
          for (int i = 0; i < 16; ++i) pv[i] = (((w >> crow(i, hh)) & 1u) != 0u) ? pv[i] : -INFINITY;
        } else if (kb2 + 31 > qw) {
#pragma unroll
          for (int i = 0; i < 16; ++i) pv[i] = (kb2 + crow(i, hh) <= query) ? pv[i] : -INFINITY;
        }
        float mx = pv[0];
#pragma unroll
        for (int i = 1; i < 16; ++i) mx = fmaxf(mx, pv[i]);
        mx = xmax32(mx);
        const float mn = fmaxf(m, mx);
        const float mu = (mn == -INFINITY) ? 0.f : mn;
        if (__any(mn != m)) {
          const float alpha = __builtin_amdgcn_exp2f(m - mu);
          l *= alpha;
#pragma unroll
          for (int db = 0; db < DV / 32; ++db) O[db] = O[db] * alpha;
          m = mn;
        }
        float ps = 0.f;
#pragma unroll
        for (int i = 0; i < 16; ++i) { pv[i] = __builtin_amdgcn_exp2f(pv[i] - mu); ps += pv[i]; }
        l += xsum32(ps);
      } else {
        float bt[16], om[16];
#pragma unroll
        for (int i = 0; i < 16; ++i) {
          const float zc = fmaxf(sacc[i], -115.f);
          const float e = __builtin_amdgcn_exp2f(-zc);
          const float bb = __builtin_amdgcn_rcpf(1.f + e);
          bt[i] = bb;
          om[i] = e * bb;
        }
        if (kb2 + 31 >= qw) {
#pragma unroll
          for (int i = 0; i < 16; ++i) {
            const bool strict = (kb2 + crow(i, hh)) < query;
            bt[i] = strict ? bt[i] : 0.f;
            om[i] = strict ? om[i] : 1.f;
          }
        }
        float go[4], gx[4];
#pragma unroll
        for (int mm = 0; mm < 4; ++mm) go[mm] = (om[4 * mm] * om[4 * mm + 1]) * (om[4 * mm + 2] * om[4 * mm + 3]);
#pragma unroll
        for (int mm = 0; mm < 4; ++mm) gx[mm] = xoth32(go[mm], hh);
        float tail = 1.f;
#pragma unroll
        for (int mm = 3; mm >= 0; --mm) {
          const float later = tail * (hh == 0 ? gx[mm] : 1.f);
          const float a3 = R * later;
          const float a2 = a3 * om[4 * mm + 3];
          const float a1 = a2 * om[4 * mm + 2];
          const float a0 = a1 * om[4 * mm + 1];
          pv[4 * mm + 3] = bt[4 * mm + 3] * a3;
          pv[4 * mm + 2] = bt[4 * mm + 2] * a2;
          pv[4 * mm + 1] = bt[4 * mm + 1] * a1;
          pv[4 * mm + 0] = bt[4 * mm + 0] * a0;
          tail *= go[mm] * gx[mm];
        }
        R *= tail;
      }
      bf16x8 pf[2];
#pragma unroll
      for (int s2 = 0; s2 < 2; ++s2) {
        u32x4 u;
#pragma unroll
        for (int j = 0; j < 4; ++j) u[j] = pk2(pv[8 * s2 + 2 * j], pv[8 * s2 + 2 * j + 1]);
        pf[s2] = __builtin_bit_cast(bf16x8, u);
      }
#pragma unroll
      for (int db = 0; db < DV / 32; ++db)
#pragma unroll
        for (int s2 = 0; s2 < 2; ++s2) {
          const char* vp = Vt + (db * 32 + r) * ROWB + (sub * 32 + 16 * s2 + 4 * hh) * 2;
          u32x2 lo = *(const u32x2*)vp, hi = *(const u32x2*)(vp + 16);
          u32x4 u; u[0] = lo[0]; u[1] = lo[1]; u[2] = hi[0]; u[3] = hi[1];
          O[db] = mfma(__builtin_bit_cast(bf16x8, u), pf[s2], O[db]);
        }
    }
  }
  lsum = l;
}

template <int DV>
DI void store_y(const P& p, int b, int q0, int ycol, const f32x16 (&O)[DV / 32]) {
  const int lane = TID() & 63, wave = TID() >> 6, r = lane & 31, hh = lane >> 5;
  const int token = b * S + q0 + wave * 32 + r;
#pragma unroll
  for (int db = 0; db < DV / 32; ++db)
#pragma unroll
    for (int g4 = 0; g4 < 4; ++g4) {
      u32x2 w; w[0] = pk2(O[db][4 * g4], O[db][4 * g4 + 1]); w[1] = pk2(O[db][4 * g4 + 2], O[db][4 * g4 + 3]);
      *(u32x2*)(p.Y + (size_t)token * NY + ycol + db * 32 + 8 * g4 + 4 * hh) = w;
    }
}

DI void attn_task_diff(const P& p, int l, int b, int h, int q0, char* lds) {
  const int lane = TID() & 63, hh = lane >> 5;
  const float* lq1 = p.in[8] + l * 64; const float* lk1 = p.in[9] + l * 64;
  const float* lq2 = p.in[10] + l * 64; const float* lk2 = p.in[11] + l * 64;
  float d1 = 0.f, d2 = 0.f;
  for (int i = 0; i < 64; ++i) { d1 += lq1[i] * lk1[i]; d2 += lq2[i] * lk2[i]; }
  const float lam_init = 0.8f - 0.6f * expf(-0.3f * (float)l);
  const float lam = expf(d1) - expf(d2) + lam_init;
  f32x16 O1[4], O2[4]; float l1, l2;
  attn_core<0, 128>(p, b, q0, AQ + h * 128, AK + h * 128, h * 128, 0, lds, O1, l1);
  const float i1 = 1.f / l1;
#pragma unroll
  for (int db = 0; db < 4; ++db)
#pragma unroll
    for (int i = 0; i < 16; ++i) O1[db][i] *= i1;
  attn_core<0, 128>(p, b, q0, AQ + h * 128 + 64, AK + h * 128 + 64, h * 128, 0, lds, O2, l2);
  const float i2 = lam / l2;
  float ss = 0.f;
#pragma unroll
  for (int db = 0; db < 4; ++db)
#pragma unroll
    for (int i = 0; i < 16; ++i) { const float v = O1[db][i] - i2 * O2[db][i]; O1[db][i] = v; ss += v * v; }
  ss = xsum32(ss);
  const float rs = rsqrtf(ss * (1.f / 128.f) + 1e-5f) * (1.f - lam_init);
  const float* dg = p.in[12] + l * 128;
#pragma unroll
  for (int db = 0; db < 4; ++db)
#pragma unroll
    for (int i = 0; i < 16; ++i) O1[db][i] *= rs * dg[db * 32 + crow(i, hh)];
  store_y<128>(p, b, q0, h * 128, O1);
}
template <int VAR>
DI void attn_task_64(const P& p, int b, int h, int q0, char* lds) {
  f32x16 O[2]; float ls;
  constexpr int qo = (VAR == 1) ? BQ : (VAR == 2 ? CQ : DQ);
  constexpr int ko = (VAR == 1) ? BKo : (VAR == 2 ? CK : DK);
  constexpr int vo = (VAR == 1) ? 512 : (VAR == 2 ? 768 : 1024);
  attn_core<VAR, 64>(p, b, q0, qo + h * 64, ko + h * 64, vo + h * 64, h, lds, O, ls);
  if (VAR != 2) {
    const float il = 1.f / ls;
#pragma unroll
    for (int db = 0; db < 2; ++db)
#pragma unroll
      for (int i = 0; i < 16; ++i) O[db][i] *= il;
  }
  store_y<64>(p, b, q0, vo + h * 64, O);
}

DI void idx_task(const P& p, int b, int t0, char* lds) {
  float* sc = (float*)lds;
  const int tid = TID(), lane = tid & 63, wave = tid >> 6, r = lane & 31, hh = lane >> 5;
  __syncthreads();
  bf16x8 afA[4], afB[4];
  {
    const u16* ap = p.PR + (size_t)(b * S + t0 + (r >> 3)) * NPR + IQ + (r & 7) * 64;
#pragma unroll
    for (int ks = 0; ks < 4; ++ks) { afA[ks] = *(const bf16x8*)(ap + ks * 16 + hh * 8); afB[ks] = *(const bf16x8*)(ap + (size_t)4 * NPR + ks * 16 + hh * 8); }
  }
  float iwA[16], iwB[16];
#pragma unroll
  for (int i = 0; i < 16; ++i) {
    iwA[i] = p.IW[(size_t)(b * S + t0 + (i >> 2)) * 8 + (i & 3) + 4 * hh];
    iwB[i] = p.IW[(size_t)(b * S + t0 + 4 + (i >> 2)) * 8 + (i & 3) + 4 * hh];
  }
  const int ntile = (t0 + 7) / 32 + 1;
  for (int tb = wave * 4; tb < ntile; tb += 32) {
    bf16x8 bb[4][4];
#pragma unroll
    for (int u = 0; u < 4; ++u) {
      const int tile = min(tb + u, ntile - 1);
      const u16* bp = p.PR + (size_t)(b * S + tile * 32 + r) * NPR + IK;
#pragma unroll
      for (int ks = 0; ks < 4; ++ks) bb[u][ks] = *(const bf16x8*)(bp + ks * 16 + hh * 8);
    }
#pragma unroll
    for (int u = 0; u < 4; ++u) {
      const int tile = tb + u;
      f32x16 accA = zero16(), accB = zero16();
#pragma unroll
      for (int ks = 0; ks < 4; ++ks) { accA = mfma(afA[ks], bb[u][ks], accA); accB = mfma(afB[ks], bb[u][ks], accB); }
      float sA[4], sB[4];
#pragma unroll
      for (int q = 0; q < 4; ++q) {
        float va = 0.f, vb = 0.f;
#pragma unroll
        for (int j = 0; j < 4; ++j) { va += fmaxf(accA[4 * q + j], 0.f) * iwA[4 * q + j]; vb += fmaxf(accB[4 * q + j], 0.f) * iwB[4 * q + j]; }
        sA[q] = xsum32(va); sB[q] = xsum32(vb);
      }
      if (tile < ntile) {
        sc[(2 * hh) * 4096 + tile * 32 + r] = hh ? sA[2] : sA[0];
        sc[(2 * hh + 1) * 4096 + tile * 32 + r] = hh ? sA[3] : sA[1];
        sc[(4 + 2 * hh) * 4096 + tile * 32 + r] = hh ? sB[2] : sB[0];
        sc[(5 + 2 * hh) * 4096 + tile * 32 + r] = hh ? sB[3] : sB[1];
      }
    }
  }
  __syncthreads();
  const int t = __builtin_amdgcn_readfirstlane(t0 + wave);
  unsigned key[64];
#pragma unroll
  for (int c = 0; c < 64; ++c) {
    const int s = c * 64 + lane;
    unsigned u = __float_as_uint(sc[wave * 4096 + s]);
    u = (u & 0x80000000u) ? ~u : (u | 0x80000000u);
    key[c] = (s <= t) ? u : 0u;
  }
  u64 mymask = 0;
  const int nch = (t >> 6) + 1;
  if (t >= 256) {
    unsigned T = 0;
    bool exact = false;
    for (int bit = 31; bit >= 0; --bit) {
      const unsigned cand = T | (1u << bit);
      int cl = 0;
#pragma unroll
      for (int g = 0; g < 8; ++g) {
        if (g * 8 < nch) {
#pragma unroll
          for (int c = g * 8; c < g * 8 + 8; ++c) cl += (key[c] >= cand) ? 1 : 0;
        }
      }
      const int cnt = wave_sum_i32(cl);
      if (cnt >= 256) T = cand;
      if (cnt == 256) { exact = true; break; }
    }
    if (exact) {
#pragma unroll
      for (int c = 0; c < 64; ++c) {
        const u64 mk = __ballot(key[c] >= T);
        if (lane == c) mymask = mk;
      }
    } else {
    int ngt = 0;
#pragma unroll
    for (int c = 0; c < 64; ++c) ngt += __popcll(__ballot(key[c] > T));
    int rem = 256 - ngt;
#pragma unroll
    for (int c = 0; c < 64; ++c) {
      const u64 gt = __ballot(key[c] > T);
      u64 eq = __ballot(key[c] == T);
      int e = __popcll(eq);
      while (e > rem) { eq &= ~(1ull << (63 - __clzll(eq))); --e; }
      rem -= e;
      const u64 mk = gt | eq;
      if (lane == c) mymask = mk;
    }
    }
  } else {
#pragma unroll
    for (int c = 0; c < 64; ++c) {
      const u64 mk = __ballot(c * 64 + lane <= t);
      if (lane == c) mymask = mk;
    }
  }
  *(u64*)(p.MASK + (size_t)(b * S + t) * 128 + lane * 2) = mymask;
}

DI void scan_task(const P& p, int pair) {
  const int lane = TID() & 63;
  const int b = pair >> 2, h = pair & 3;
  const float* src = p.FL + ((size_t)(b * S + lane * 64)) * 4 + h;
  float v[64];
#pragma unroll
  for (int j = 0; j < 64; ++j) v[j] = src[j * 4];
#pragma unroll
  for (int j = 1; j < 64; ++j) v[j] += v[j - 1];
  float tot = v[63], inc = tot;
#pragma unroll
  for (int o = 1; o < 64; o <<= 1) { const float u = __shfl_up(inc, o); if (lane >= o) inc += u; }
  const float off = inc - tot;
  float* dst = p.CUM + (size_t)pair * S + lane * 64;
#pragma unroll
  for (int j = 0; j < 64; j += 4) {
    f32x4 o4; o4[0] = v[j] + off; o4[1] = v[j + 1] + off; o4[2] = v[j + 2] + off; o4[3] = v[j + 3] + off;
    *(f32x4*)(dst + j) = o4;
  }
}

DI int zz_id(int r) { const int G = gridDim.x, bb = blockIdx.x; return r * G + ((r & 1) ? (G - 1 - bb) : bb); }
DI bool attn_map(int r, int& bh, int& qt) {
  if (gridDim.x == 256) {
    if (r >= 2) return false;
    const int x = blockIdx.x & 7, jb = blockIdx.x >> 3;
    bh = 4 * x + (jb >> 3);
    qt = (r == 0) ? 15 - (jb & 7) : (jb & 7);
    return true;
  }
  if (r * (int)gridDim.x >= 512) return false;
  const int id = zz_id(r);
  if (id >= 512) { bh = -1; return true; }
  bh = id & 31; qt = 15 - (id >> 5);
  return true;
}
DI void phase_mix1(const P& p, int l, char* lds) {
  for (int task = blockIdx.x; task < 4; task += gridDim.x) scan_task(p, task * 8 + (TID() >> 6));
  for (int r = 0; r * (int)gridDim.x < 4096; ++r) {
    const int id = zz_id(r); if (id >= 4096) continue;
    const int trev = id >> 3, b = id & 7;
    idx_task(p, b, (511 - trev) * 8, lds);
  }
  int bh, qt;
  for (int r = 0; attn_map(r, bh, qt); ++r) { if (bh >= 0) attn_task_diff(p, l, bh >> 2, bh & 3, qt * 256, lds); }
  for (int r = 0; attn_map(r, bh, qt); ++r) { if (bh >= 0) attn_task_64<2>(p, bh >> 2, bh & 3, qt * 256, lds); }
}
DI void phase_mix2(const P& p, char* lds) {
  int bh, qt;
  for (int r = 0; attn_map(r, bh, qt); ++r) { if (bh >= 0) attn_task_64<1>(p, bh >> 2, bh & 3, qt * 256, lds); }
  for (int r = 0; attn_map(r, bh, qt); ++r) { if (bh >= 0) attn_task_64<3>(p, bh >> 2, bh & 3, qt * 256, lds); }
}

__global__ void __launch_bounds__(512, 2) mega_kernel(P p) {
  __shared__ __attribute__((aligned(16))) char lds[LDS_BYTES];
  cg::grid_group grid = cg::this_grid();
  u16* act = p.PR; u16* merged = p.PR;
  for (int l = 0; l < 2; ++l) {
    const float* xcur = (l == 0) ? p.in[0] : p.xres;
    phase_conv(p, l, lds); phase_norm(xcur, p.in[2] + l * D, p.hb); grid.sync();
    phase_gu(p, p.Wt + OFF_GU1, act, lds); grid.sync();
    phase_resid(p.Wt + OFF_DN1, act, DFF, xcur, p.xres, 0.5f, lds); grid.sync();
    phase_norm(p.xres, p.in[5] + l * D, p.hb); grid.sync();
    phase_proj(p, l, lds); grid.sync();
    phase_mix1(p, l, lds); grid.sync();
    phase_mix2(p, lds); grid.sync();
    phase_merge(p, l, merged, lds); grid.sync();
    phase_resid(p.Wt + OFF_OUT, merged, D, p.xres, p.xres, 1.0f, lds); grid.sync();
    phase_norm(p.xres, p.in[20] + l * D, p.hb); grid.sync();
    phase_gu(p, p.Wt + OFF_GU2, act, lds); grid.sync();
    phase_resid(p.Wt + OFF_DN2, act, DFF, p.xres, p.xres, 0.5f, lds); grid.sync();
  }
  phase_final_norm(p.xres, p.in[23]);
}

extern "C" void kernel_launch(void* const* d_in, const int* in_sizes, int n_in, void* d_out, int out_size, void* d_ws, size_t ws_size, hipStream_t stream) {
  P p{};
  for (int i = 0; i < 24; ++i) p.in[i] = (const float*)d_in[i];
  p.pos = (const int*)d_in[1];
  p.xres = (float*)d_out;
  char* w = (char*)d_ws; size_t off = 0;
  auto take = [&](size_t bytes) { char* r = w + off; off += (bytes + 255) & ~(size_t)255; return r; };
  p.Wt = (u16*)take(WT_ELEMS * 2);
  p.hb = (u16*)take((size_t)M * D * 2);
  p.PR = (u16*)take((size_t)M * NPR * 2);
  p.VT = (u16*)take((size_t)NB * NV * S * 2);
  p.Y = (u16*)take((size_t)M * NY * 2);
  p.MASK = (unsigned*)take((size_t)M * 128 * 4);
  p.FL = (float*)take((size_t)M * 4 * 4);
  p.IW = (float*)take((size_t)M * 8 * 4);
  p.CUM = (float*)take((size_t)M * 4 * 4);
  p.COS = (float*)take((size_t)S * 8 * 4);
  p.SIN = (float*)take((size_t)S * 8 * 4);
  if (off > ws_size) { fprintf(stderr, "workspace too small: need %zu have %zu\n", off, ws_size); return; }
  static int grid_blocks = 0;
  if (!grid_blocks) {
    int dev = 0, cus = 0, per_cu = 0;
    hipGetDevice(&dev);
    hipDeviceGetAttribute(&cus, hipDeviceAttributeMultiprocessorCount, dev);
    hipOccupancyMaxActiveBlocksPerMultiprocessor(&per_cu, mega_kernel, 512, 0);
    grid_blocks = cus * (per_cu < 1 ? 1 : per_cu);
  }
  void* args[] = {&p};
  hipError_t e = hipLaunchCooperativeKernel((void*)mega_kernel, dim3(grid_blocks), dim3(512), args, 0, stream);
  if (e != hipSuccess) fprintf(stderr, "cooperative launch failed: %s (grid %d)\n", hipGetErrorString(e), grid_blocks);
}
```
